# Optimizing an MI355X kernel written in HIP

```python
import math
import jax
import jax.numpy as jnp
from jax import lax
import numpy as np

D_MODEL = 2048
BATCH = 4
SEQ = 2048
DEPTH = 4

A_W = D_MODEL // 2
A_GROUPS = 8
A_GW = A_W // A_GROUPS
CHUNK = 128
B_W = D_MODEL // 2
HY_ORDER = 2
HY_EMB = 33
HY_FW = 64
HY_MIN_DECAY = -math.log(1e-2) / 1.5
HY_MAX_DECAY = -math.log(1e-2) / 0.3
C_N = 64
C_W = D_MODEL // 2
C_H = C_W // C_N
W_LORA = 48
A_LORA = 48
V_LORA = 32
G_LORA = 128
N_DIR = 2
N_BRANCH = 3
C_IN = 3 * C_W + G_LORA + N_DIR * W_LORA + N_DIR * A_LORA
N_IN = 2 * A_W + 3 * B_W + C_IN + N_BRANCH * D_MODEL
D_FF = -(-8 * D_MODEL // (3 * 256)) * 256
RMS_EPS = 1e-6
LN_EPS = 1e-5
GN_EPS = 64e-5

kernel_name = 'hybrid_gmlp_hyena_rwkv7_bidir_encoder'


def rms_norm(x, g):
    xf = x.astype(jnp.float32)
    y = xf * lax.rsqrt(jnp.mean(xf * xf, axis=-1, keepdims=True) + RMS_EPS)
    return (y * g.astype(jnp.float32)).astype(x.dtype)


def norm_last(x, eps):
    xf = x.astype(jnp.float32)
    mu = jnp.mean(xf, axis=-1, keepdims=True)
    var = jnp.mean(jnp.square(xf - mu), axis=-1, keepdims=True)
    return (xf - mu) * lax.rsqrt(var + eps)


def shift_prev(z):
    return jnp.pad(z[:, :-1], ((0, 0), (1, 0), (0, 0)))


def shift_next(z):
    return jnp.pad(z[:, 1:], ((0, 0), (0, 1), (0, 0)))


def spatial_gating(u_raw, v_raw, ln_g, ln_b, ws, bs):
    bsz, seq, _ = u_raw.shape
    u = jax.nn.gelu(u_raw, approximate=False)
    v = jax.nn.gelu(v_raw, approximate=False)
    v = (norm_last(v, LN_EPS) * ln_g.astype(jnp.float32) + ln_b.astype(jnp.float32)).astype(u.dtype)
    vc = v.reshape(bsz, seq // CHUNK, CHUNK, A_GROUPS, A_GW)
    s = jnp.einsum('gpq,bcqgd->bcpgd', ws, vc) + bs.T[:, :, None]
    return u * s.reshape(bsz, seq, A_W)


def hyena_filter_spectrum(seq, w1, b1, w2, b2, w3, b3, w4, freq, log_decay):
    w1, b1, w2, b2, w3, b3, w4, freq, log_decay = (
        p.astype(jnp.float32) for p in (w1, b1, w2, b2, w3, b3, w4, freq, log_decay))
    t = jnp.linspace(0.0, 1.0, seq, dtype=jnp.float32)[:, None]
    bands = (HY_EMB - 1) // 2
    fr = jnp.linspace(1e-4, bands - 1, bands, dtype=jnp.float32)
    ang = (2.0 * math.pi / seq) * jnp.arange(seq, dtype=jnp.float32)[:, None] * fr[None, :]
    feats = jnp.concatenate([t, jnp.cos(ang), -jnp.sin(ang)], axis=-1)
    z = jnp.sin(freq * (feats @ w1 + b1))
    z = jnp.sin(freq * (z @ w2 + b2))
    z = jnp.sin(freq * (z @ w3 + b3))
    h = (z @ w4).reshape(seq, N_DIR, HY_ORDER, B_W)
    h = h * jnp.exp(-t[:, :, None, None] * jnp.exp(log_decay)[None])
    h = h / jnp.sum(jnp.abs(h), axis=(0, 1), keepdims=True)
    taps = jnp.concatenate(
        [h[:, 0], jnp.zeros((1, HY_ORDER, B_W), jnp.float32), h[:0:-1, 1]], axis=0)
    return jnp.fft.rfft(taps, axis=0)


def long_conv(z, spec, skip):
    seq = z.shape[1]
    zf = jnp.fft.rfft(z.astype(jnp.float32), n=2 * seq, axis=1)
    y = jnp.fft.irfft(zf * spec[None], n=2 * seq, axis=1)[:, :seq]
    return (y + skip.astype(jnp.float32) * z.astype(jnp.float32)).astype(z.dtype)


def hyena_mixer(cols, conv_w, conv_b, w1, b1, w2, b2, w3, b3, w4, freq, log_decay, bias_d):
    zc = conv_w[0] * shift_prev(cols) + conv_w[1] * cols + conv_w[2] * shift_next(cols) + conv_b
    x1, x2, v = jnp.split(zc, 3, axis=-1)
    spec = hyena_filter_spectrum(cols.shape[1], w1, b1, w2, b2, w3, b3, w4, freq, log_decay)
    z = x1 * long_conv(v, spec[:, 0], bias_d[0])
    return x2 * long_conv(z, spec[:, 1], bias_d[1])


def to_scan(z_fwd, z_bwd):
    return jnp.stack([z_fwd, z_bwd[:, ::-1]], axis=0).transpose(2, 0, 1, 3, 4).astype(jnp.float32)


def wkv7_scan(r, w, k, v, a, b):
    s0 = jnp.zeros(r.shape[1:] + (C_N,), jnp.float32)

    def step(s, inp):
        r_t, w_t, k_t, v_t, a_t, b_t = inp
        sa = jnp.einsum('dbhij,dbhj->dbhi', s, a_t)
        s = s * w_t[..., None, :] + sa[..., :, None] * b_t[..., None, :] + v_t[..., :, None] * k_t[..., None, :]
        return s, jnp.einsum('dbhij,dbhj->dbhi', s, r_t)

    _, y = lax.scan(step, s0, (r, w, k, v, a, b))
    return y


def rwkv7_mixer(cols, v_first, v_mix, mu_prev, mu_next, w0, w2, a0, a2, g2, k_k, k_a, r_k, ln_g, ln_b):
    bsz, seq, _ = cols.shape
    c = cols + mu_prev * (shift_prev(cols) - cols) + mu_next * (shift_next(cols) - cols)
    r, k, v, gd, wd, ad = jnp.split(
        c, [C_W, 2 * C_W, 3 * C_W, 3 * C_W + G_LORA, 3 * C_W + G_LORA + N_DIR * W_LORA], axis=-1)
    wd = wd.reshape(bsz, seq, N_DIR, W_LORA)
    ad = ad.reshape(bsz, seq, N_DIR, A_LORA)
    w_log = -jax.nn.softplus(-(w0 + jnp.einsum('btdr,drc->btdc', jnp.tanh(wd), w2))) - 0.5
    decay = jnp.exp(-jnp.exp(w_log))
    a = jax.nn.sigmoid(a0 + jnp.einsum('btdr,drc->btdc', ad, a2))
    if v_mix is None:
        v_first = v
    else:
        v0, v1, v2 = v_mix
        v = v + (v_first - v) * jax.nn.sigmoid(v0 + (v @ v1) @ v2)
    g = jax.nn.sigmoid(gd) @ g2
    heads = (bsz, seq, C_H, C_N)
    dheads = (bsz, seq, N_DIR, C_H, C_N)
    kk = (k * k_k).reshape(heads).astype(jnp.float32)
    kk = kk / jnp.maximum(jnp.sqrt(jnp.sum(kk * kk, axis=-1, keepdims=True)), 1e-12)
    k_d = (k[:, :, None] * (1.0 + (a - 1.0) * k_a)).reshape(dheads)
    a_h = a.reshape(dheads)
    decay_h = decay.reshape(dheads)
    r_h = r.reshape(heads)
    v_h = v.reshape(heads)
    y = wkv7_scan(
        to_scan(r_h, r_h),
        to_scan(decay_h[:, :, 0], decay_h[:, :, 1]),
        to_scan(k_d[:, :, 0], k_d[:, :, 1]),
        to_scan(v_h, v_h),
        to_scan(-kk, -kk),
        to_scan(kk * a_h[:, :, 0], kk * a_h[:, :, 1]))
    y = (y[:, 0] + y[::-1, 1]).transpose(1, 0, 2, 3)
    y = norm_last(y, GN_EPS).reshape(bsz, seq, C_W) * ln_g.astype(jnp.float32) + ln_b.astype(jnp.float32)
    bonus = jnp.sum(r_h[:, :, None] * k_d * r_k, axis=(2, 4))[..., None] * v_h
    out = (y + bonus.reshape(bsz, seq, C_W).astype(jnp.float32)) * g.astype(jnp.float32)
    return out.astype(cols.dtype), v_first


def setup_inputs(seed: int = 0) -> dict:
    key = jax.random.key(seed)
    keys = iter(jax.random.split(key, 64))
    L = DEPTH

    def nrm(shape, scale):
        return scale * jax.random.normal(next(keys), shape, jnp.float32)

    def unif(shape, lo, hi):
        return jax.random.uniform(next(keys), shape, jnp.float32, lo, hi)

    return {
        'x': nrm((BATCH, SEQ, D_MODEL), 1.0),
        'norm_mix_g': 1.0 + nrm((L, D_MODEL), 0.02),
        'w_in': nrm((L, D_MODEL, N_IN), D_MODEL ** -0.5),
        'gm_ln_g': 1.0 + nrm((L, A_W), 0.02),
        'gm_ln_b': nrm((L, A_W), 0.02),
        'gm_ws': nrm((L, A_GROUPS, CHUNK, CHUNK), CHUNK ** -0.5),
        'gm_bs': 1.0 + nrm((L, A_GROUPS, CHUNK), 0.1),
        'hy_conv_w': nrm((L, 3, 3 * B_W), 0.5),
        'hy_conv_b': nrm((L, 3 * B_W), 0.02),
        'hy_w1': nrm((L, HY_EMB, HY_FW), HY_EMB ** -0.5),
        'hy_b1': nrm((L, HY_FW), 0.02),
        'hy_w2': nrm((L, HY_FW, HY_FW), HY_FW ** -0.5),
        'hy_b2': nrm((L, HY_FW), 0.02),
        'hy_w3': nrm((L, HY_FW, HY_FW), HY_FW ** -0.5),
        'hy_b3': nrm((L, HY_FW), 0.02),
        'hy_w4': nrm((L, HY_FW, N_DIR * HY_ORDER * B_W), HY_FW ** -0.5),
        'hy_freq': 1.0 + nrm((L, HY_FW), 0.1),
        'hy_log_decay': unif((L, N_DIR, HY_ORDER, B_W), math.log(HY_MIN_DECAY), math.log(HY_MAX_DECAY)),
        'hy_bias_d': nrm((L, HY_ORDER, B_W), 0.5),
        'rw_mu_prev': unif((L, C_IN), 0.0, 0.5),
        'rw_mu_next': unif((L, C_IN), 0.0, 0.5),
        'rw_w0': unif((L, N_DIR, C_W), -6.0, -1.0),
        'rw_w2': nrm((L, N_DIR, W_LORA, C_W), 0.5 * W_LORA ** -0.5),
        'rw_a0': nrm((L, N_DIR, C_W), 0.1),
        'rw_a2': nrm((L, N_DIR, A_LORA, C_W), A_LORA ** -0.5),
        'rw_v0': 1.0 + nrm((L - 1, C_W), 0.1),
        'rw_v1': nrm((L - 1, C_W, V_LORA), C_W ** -0.5),
        'rw_v2': nrm((L - 1, V_LORA, C_W), V_LORA ** -0.5),
        'rw_g2': nrm((L, G_LORA, C_W), G_LORA ** -0.5),
        'rw_k_k': 0.85 + nrm((L, C_W), 0.02),
        'rw_k_a': 1.0 + nrm((L, C_W), 0.02),
        'rw_r_k': nrm((L, C_H, C_N), 0.1),
        'rw_ln_g': 1.0 + nrm((L, C_W), 0.02),
        'rw_ln_b': nrm((L, C_W), 0.02),
        'w_branch_a': nrm((L, A_W, D_MODEL), A_W ** -0.5),
        'w_branch_b': nrm((L, B_W, D_MODEL), B_W ** -0.5),
        'w_branch_c': nrm((L, C_W, D_MODEL), C_W ** -0.5),
        'w_out': nrm((L, D_MODEL, D_MODEL), D_MODEL ** -0.5),
        'norm_ffn_g': 1.0 + nrm((L, D_MODEL), 0.02),
        'w_ffn_gate': nrm((L, D_MODEL, D_FF), D_MODEL ** -0.5),
        'w_ffn_up': nrm((L, D_MODEL, D_FF), D_MODEL ** -0.5),
        'w_ffn_down': nrm((L, D_FF, D_MODEL), D_FF ** -0.5),
        'norm_final_g': 1.0 + nrm((D_MODEL,), 0.02),
    }


def reference(x, norm_mix_g, w_in, gm_ln_g, gm_ln_b, gm_ws, gm_bs, hy_conv_w, hy_conv_b,
              hy_w1, hy_b1, hy_w2, hy_b2, hy_w3, hy_b3, hy_w4, hy_freq, hy_log_decay, hy_bias_d,
              rw_mu_prev, rw_mu_next, rw_w0, rw_w2, rw_a0, rw_a2, rw_v0, rw_v1, rw_v2, rw_g2,
              rw_k_k, rw_k_a, rw_r_k, rw_ln_g, rw_ln_b, w_branch_a, w_branch_b, w_branch_c, w_out,
              norm_ffn_g, w_ffn_gate, w_ffn_up, w_ffn_down, norm_final_g):
    bsz, seq, _ = x.shape
    v_first = None
    for l in range(DEPTH):
        h = rms_norm(x, norm_mix_g[l])
        proj = h @ w_in[l]
        a_cols, b_cols, c_cols, gate_cols = jnp.split(
            proj, [2 * A_W, 2 * A_W + 3 * B_W, 2 * A_W + 3 * B_W + C_IN], axis=-1)
        u, v = jnp.split(a_cols, 2, axis=-1)
        y_a = spatial_gating(u, v, gm_ln_g[l], gm_ln_b[l], gm_ws[l], gm_bs[l])
        y_b = hyena_mixer(b_cols, hy_conv_w[l], hy_conv_b[l], hy_w1[l], hy_b1[l], hy_w2[l], hy_b2[l],
                          hy_w3[l], hy_b3[l], hy_w4[l], hy_freq[l], hy_log_decay[l], hy_bias_d[l])
        v_mix = None if l == 0 else (rw_v0[l - 1], rw_v1[l - 1], rw_v2[l - 1])
        y_c, v_first = rwkv7_mixer(c_cols, v_first, v_mix, rw_mu_prev[l], rw_mu_next[l], rw_w0[l], rw_w2[l],
                                   rw_a0[l], rw_a2[l], rw_g2[l], rw_k_k[l], rw_k_a[l], rw_r_k[l],
                                   rw_ln_g[l], rw_ln_b[l])
        gates = jax.nn.sigmoid(gate_cols).reshape(bsz, seq, N_BRANCH, D_MODEL)
        merged = (gates[:, :, 0] * (y_a @ w_branch_a[l])
                  + gates[:, :, 1] * (y_b @ w_branch_b[l])
                  + gates[:, :, 2] * (y_c @ w_branch_c[l]))
        x = x + merged @ w_out[l]
        h = rms_norm(x, norm_ffn_g[l])
        x = x + (jax.nn.silu(h @ w_ffn_gate[l]) * (h @ w_ffn_up[l])) @ w_ffn_down[l]
    return rms_norm(x, norm_final_g)
```

```cpp
#include <hip/hip_runtime.h>
#include <cstdio>
#include <cstdint>

#ifndef MK_LAUNCH_PER_PHASE
#define MK_LAUNCH_PER_PHASE 0
#endif

#define GAS __attribute__((address_space(1)))
#define LAS __attribute__((address_space(3)))
typedef unsigned short bf16_t;
typedef short bf16x8 __attribute__((ext_vector_type(8)));
typedef float f32x4 __attribute__((ext_vector_type(4)));
typedef float f32x2 __attribute__((ext_vector_type(2)));
typedef unsigned u32x4 __attribute__((ext_vector_type(4)));
typedef unsigned u32x2 __attribute__((ext_vector_type(2)));

constexpr int NB = 4, T = 2048, M = NB * T, D = 2048, DEPTH = 4;
constexpr int AW = 1024, AG = 8, CHUNK = 128;
constexpr int BW = 1024;
constexpr int CW = 1024, CH = 16, CN = 64, WL = 48, AL = 48, VL = 32, GL = 128;
constexpr int CIN = 3 * CW + GL + 2 * WL + 2 * AL;
constexpr int CINP = 3584;
constexpr int NIN = 2 * AW + 3 * BW + CIN + 3 * D;
constexpr int DFF = 5632;
constexpr int HYF = 64, HYE = 33;
constexpr float RMS_EPS = 1e-6f, LN_EPS = 1e-5f, GN_EPS = 64e-5f;
constexpr int NIN_MAIN = 2 * AW + CINP + 3 * D;
constexpr int NINP = NIN_MAIN + 3 * BW;

enum { I_X = 0, I_NORM_MIX_G, I_W_IN, I_GM_LN_G, I_GM_LN_B, I_GM_WS, I_GM_BS, I_HY_CONV_W, I_HY_CONV_B, I_HY_W1, I_HY_B1, I_HY_W2, I_HY_B2, I_HY_W3, I_HY_B3, I_HY_W4,
       I_HY_FREQ, I_HY_LOG_DECAY, I_HY_BIAS_D, I_RW_MU_PREV, I_RW_MU_NEXT, I_RW_W0, I_RW_W2, I_RW_A0, I_RW_A2, I_RW_V0, I_RW_V1, I_RW_V2, I_RW_G2, I_RW_K_K, I_RW_K_A,
       I_RW_R_K, I_RW_LN_G, I_RW_LN_B, I_W_BR_A, I_W_BR_B, I_W_BR_C, I_W_OUT, I_NORM_FFN_G, I_W_FFN_GATE, I_W_FFN_UP, I_W_FFN_DOWN, I_NORM_FINAL_G, N_INPUTS };

constexpr size_t MiB = 1u << 20;
constexpr size_t WS_CTL = 0, CTL_ZERO_BYTES = 1 * MiB;
constexpr size_t WS_WIN = 2 * MiB;
constexpr size_t WIN_L = (size_t)NINP * D * 2;
constexpr size_t WS_WBR = WS_WIN + 4 * WIN_L;
constexpr size_t WBR_L = (size_t)3 * D * 1024 * 2;
constexpr size_t WS_WOUT = WS_WBR + 4 * WBR_L;
constexpr size_t WOUT_L = (size_t)D * D * 2;
constexpr size_t WS_WGU = WS_WOUT + 4 * WOUT_L;
constexpr size_t WGU_L = (size_t)2 * DFF * D * 2;
constexpr size_t WS_WDN = WS_WGU + 4 * WGU_L;
constexpr size_t WDN_L = (size_t)D * DFF * 2;
constexpr size_t WS_HF = WS_WDN + 4 * WDN_L;
constexpr size_t HF_L = (size_t)2 * 1024 * 4096 * 4;
constexpr size_t WS_Z3 = WS_HF + 4 * HF_L;
constexpr size_t WS_X = WS_Z3 + 2 * MiB;
constexpr size_t WS_H = WS_X + (size_t)M * D * 4;
constexpr size_t WS_PA = WS_H + (size_t)M * D * 2;
constexpr size_t WS_PC = WS_PA + (size_t)M * 2048 * 2;
constexpr size_t WS_PG = WS_PC + (size_t)M * CINP * 2;
constexpr size_t WS_PB = WS_PG + (size_t)M * 6144 * 2;
constexpr size_t WS_STATS = WS_PB + (size_t)3072 * M * 2;
constexpr size_t WS_R = WS_STATS + 1 * MiB;
constexpr size_t ACT1K = (size_t)M * 1024 * 4;
constexpr size_t WS_V = WS_R + ACT1K;
constexpr size_t WS_AA = WS_V + ACT1K;
constexpr size_t WS_WD = WS_AA + ACT1K;
constexpr size_t WS_KD = WS_WD + 2 * ACT1K;
constexpr size_t WS_BD = WS_KD + 2 * ACT1K;
constexpr size_t WS_GG = WS_BD + 2 * ACT1K;
constexpr size_t WS_VFIRST = WS_GG + ACT1K;
constexpr size_t WS_YS = WS_VFIRST + ACT1K;
constexpr size_t WS_YA = WS_YS + 2 * ACT1K;
constexpr size_t WS_YB = WS_YA + (size_t)M * 1024 * 2;
constexpr size_t WS_YC = WS_YB + (size_t)M * 1024 * 2;
constexpr size_t WS_PBR = WS_YC + (size_t)M * 1024 * 2;
constexpr size_t WS_MERGED = WS_PBR + (size_t)3 * M * D * 2;
constexpr size_t WS_ACT = WS_MERGED + (size_t)M * D * 2;
constexpr size_t WS_END = WS_ACT + (size_t)M * DFF * 2;

constexpr int CW_BAR = 4096;

constexpr int LDS_BYTES = 147456;
constexpr int LDS_MISC_OFF = 145408;
constexpr int NTHREADS = 512, NWAVES = 8;

__device__ __forceinline__ unsigned f2bf(float f) { unsigned u = __builtin_bit_cast(unsigned, f); return (u + 0x7fffu + ((u >> 16) & 1u)) >> 16; }
__device__ __forceinline__ unsigned pk2(float lo, float hi) { return f2bf(lo) | (f2bf(hi) << 16); }
__device__ __forceinline__ float bf2f(unsigned h) { return __builtin_bit_cast(float, h << 16); }
__device__ __forceinline__ float bflo(unsigned w) { return __builtin_bit_cast(float, w << 16); }
__device__ __forceinline__ float bfhi(unsigned w) { return __builtin_bit_cast(float, w & 0xffff0000u); }
__device__ __forceinline__ float wave_sum(float v) {
#pragma unroll
    for (int o = 1; o < 64; o <<= 1) v += __shfl_xor(v, o);
    return v;
}
__device__ __forceinline__ int opaque_tid() { int t = threadIdx.x; asm volatile("" : "+v"(t)); return t; }
__device__ __forceinline__ float sigmoidf_(float x) { return 1.f / (1.f + __expf(-x)); }
__device__ __forceinline__ float gelu_exact(float x) { return 0.5f * x * (1.f + erff(x * 0.70710678118654752f)); }

#define XB_TMO      128
#define XB_XCNT(j)  (256  + 64 * (j))
#define XB_XSUB(j)  (1280 + 64 * (j))
#define XB_XGEN(j)  (2304 + 64 * (j))
#define XB_TOP      3328
#define XB_TOPGEN   3392
#define XCD_BAR_WORDS 3456
#define XB_SPIN_CAP (1u << 18)

__device__ __forceinline__ unsigned xb_ld(unsigned* p)              { return __hip_atomic_load(p, __ATOMIC_RELAXED, __HIP_MEMORY_SCOPE_AGENT); }
__device__ __forceinline__ unsigned xb_add(unsigned* p, unsigned v) { return __hip_atomic_fetch_add(p, v, __ATOMIC_RELAXED, __HIP_MEMORY_SCOPE_AGENT); }
__device__ __forceinline__ unsigned xb_xcc_id() { return (unsigned)__builtin_amdgcn_s_getreg((3 << 11) | 20) & 0xFu; }
#define XB_SPIN(cond, bar) do { unsigned _sp = 0; while (cond) { __builtin_amdgcn_s_sleep(1); \
    if ((++_sp & 255u) == 0u) { if (xb_ld(&(bar)[XB_TMO])) break; if (_sp > XB_SPIN_CAP) { atomicAdd(&(bar)[XB_TMO], 1u); break; } } } } while (0)

struct XcdBarrier { unsigned* bar; unsigned x; volatile LAS unsigned* st; };

__device__ __forceinline__ XcdBarrier xcd_barrier_post(unsigned* bar, volatile LAS unsigned* st) {
    XcdBarrier b; b.bar = bar; b.x = xb_xcc_id(); b.st = st;
    if (threadIdx.x == 0) (void)xb_add(&bar[XB_XCNT(b.x)], 1u);
    return b;
}
__device__ __forceinline__ void xcd_barrier_complete(unsigned* bar, unsigned x, unsigned& nloc, unsigned& nx) {
    const unsigned G = gridDim.x * gridDim.y * gridDim.z;
    unsigned sum, cnt, mine, sp = 0u;
    for (;;) {
        sum = 0u; cnt = 0u; mine = 0u;
#pragma unroll
        for (unsigned j = 0; j < 16; ++j) { const unsigned c = xb_ld(&bar[XB_XCNT(j)]); sum += c; cnt += (c > 0u) ? 1u : 0u; mine = (j == x) ? c : mine; }
        if (sum == G) break;
        __builtin_amdgcn_s_sleep(1);
        if ((++sp & 255u) == 0u) { if (xb_ld(&bar[XB_TMO])) break; if (sp > XB_SPIN_CAP) { atomicAdd(&bar[XB_TMO], 1u); break; } }
    }
    nloc = mine > 0u ? mine : 1u; nx = cnt > 0u ? cnt : 1u;
}
__device__ __forceinline__ void xcd_barrier(const XcdBarrier& b) {
    asm volatile("s_waitcnt vmcnt(0)" ::: "memory");
    __syncthreads();
    if (threadIdx.x == 0) {
        unsigned* bar = b.bar;
        __builtin_amdgcn_s_waitcnt(0);
        unsigned nloc = b.st[0], nx = b.st[1];
        if (nloc == 0u) { xcd_barrier_complete(bar, b.x, nloc, nx); b.st[0] = nloc; b.st[1] = nx; }
        const unsigned old = xb_add(&bar[XB_XSUB(b.x)], 1u);
        const unsigned gen = old / nloc;
        if (old + 1u == (gen + 1u) * nloc) {
            __builtin_amdgcn_fence(__ATOMIC_RELEASE, "agent");
            asm volatile("s_waitcnt vmcnt(0)" ::: "memory");
            const unsigned og = xb_add(&bar[XB_TOP], 1u);
            const unsigned tg = og / nx;
            if (og + 1u == (tg + 1u) * nx) xb_add(&bar[XB_TOPGEN], 1u);
            else XB_SPIN(xb_ld(&bar[XB_TOPGEN]) == tg, bar);
            __builtin_amdgcn_fence(__ATOMIC_ACQUIRE, "agent");
            xb_add(&bar[XB_XGEN(b.x)], 1u);
            asm volatile("s_waitcnt vmcnt(0)" ::: "memory");
        } else {
            XB_SPIN(xb_ld(&bar[XB_XGEN(b.x)]) == gen, bar);
            __builtin_amdgcn_fence(__ATOMIC_ACQUIRE, "agent");
            asm volatile("s_waitcnt vmcnt(0)" ::: "memory");
        }
    }
    __syncthreads();
}

namespace pg8 {
constexpr int BM = 256, BK = 64, HALF = 128, HTB = HALF * BK * 2, STAGE_BYTES = 8 * HTB, NXCD = 8, WGM = 8;
__host__ __device__ __forceinline__ int lds_byte(int r, int c) { const int st = (r >> 4) * 2 + (c >> 5), rr = r & 15, cc = c & 31, ob = rr * 64 + cc * 2; return st * 1024 + (ob ^ (((ob >> 9) & 1) << 5)); }
__host__ __device__ __forceinline__ void stage_rc(int b, int& R, int& C) { const int st = b / 1024, sb = b % 1024, swz = sb ^ (((sb >> 9) & 1) << 5); R = (st >> 1) * 16 + swz / 64; C = (st & 1) * 32 + (swz % 64) / 2; }
__host__ __device__ __forceinline__ int perm32(int rho) { const int n = rho >> 4, i = rho & 15; return 8 * (i >> 2) + 4 * n + (i & 3); }

struct Unit { int pm, pn, seg; };
struct SegOrder {
    const bf16_t* A0; const bf16_t* B0; int nM0, nN0;
    const bf16_t* A1; const bf16_t* B1; int nM1, nN1;
    int G, c;
    __device__ __forceinline__ static void map(int L, int nM, int nN, int& pm, int& pn) {
        const int nwg = nM * nN; int wgid = L;
        { const int q = nwg / NXCD, r = nwg % NXCD, xcd = wgid % NXCD, off = wgid / NXCD; wgid = (xcd < r ? xcd * (q + 1) : r * (q + 1) + (xcd - r) * q) + off; }
        const int nig = WGM * nN, gid = wgid / nig, fm = gid * WGM, gsz = (nM - fm) < WGM ? (nM - fm) : WGM;
        pm = fm + ((wgid % nig) % gsz); pn = (wgid % nig) / gsz;
    }
    __device__ __forceinline__ bool next(int i, Unit& u) const {
        long L = (long)i * G + c; const int n0 = nM0 * nN0, n1 = nM1 * nN1;
        if (L < n0) { u.seg = 0; map((int)L, nM0, nN0, u.pm, u.pn); return true; }
        L -= n0;
        if (L < n1) { u.seg = 1; map((int)L, nM1, nN1, u.pm, u.pn); return true; }
        return false;
    }
    __device__ __forceinline__ const char* abase(const Unit& u) const { return (const char*)(u.seg ? A1 : A0); }
    __device__ __forceinline__ const char* bbase(const Unit& u) const { return (const char*)(u.seg ? B1 : B0); }
};

__device__ __forceinline__ unsigned cvt_pk_bf16(float lo, float hi) { unsigned r; asm volatile("v_cvt_pk_bf16_f32 %0, %1, %2" : "=v"(r) : "v"(lo), "v"(hi)); return r; }
__device__ __forceinline__ f32x2 gelu_pk(f32x2 v) {
    const f32x2 av = __builtin_elementwise_abs(v), d = av * 0.2316418882f + 1.0f;
    f32x2 t; t.x = __builtin_amdgcn_rcpf(d.x); t.y = __builtin_amdgcn_rcpf(d.y);
    f32x2 q = t * 0.5307027145f + (-0.7265760135f); q = q * t + 0.7107068705f; q = q * t + (-0.142248368f); q = q * t + 0.127414796f; q = q * t;
    const f32x2 s = (v * v) * (-0.72134752044f);
    f32x2 e; e.x = __builtin_amdgcn_exp2f(s.x); e.y = __builtin_amdgcn_exp2f(s.y);
    const f32x2 m = v * (q * e), r = v - m;
    f32x2 o; o.x = v.x < 0.f ? m.x : r.x; o.y = v.y < 0.f ? m.y : r.y; return o;
}
__device__ __forceinline__ float fast_sigmoid(float x) { return __builtin_amdgcn_rcpf(1.f + __builtin_amdgcn_exp2f(-1.4426950408889634f * x)); }

struct EpiInProj {
    bf16_t *PA, *PC, *PG, *PB;
    __device__ __forceinline__ void operator()(const f32x4 (&acc)[2][2][4][2], const Unit& u, int wr, int wc, int fr, int fq) const {
        const int row0 = u.pm * BM + wr * 64 + fr;
        int mode, ldc, colt; bf16_t* base;
        if (u.seg == 1) { mode = 0; ldc = M; colt = u.pn * BM; base = PB; }
        else if (u.pn < 8) { mode = 1; ldc = 2048; colt = u.pn * BM; base = PA; }
        else if (u.pn < 22) { mode = 0; ldc = CINP; colt = (u.pn - 8) * BM; base = PC; }
        else { mode = 2; ldc = 6144; colt = (u.pn - 22) * BM; base = PG; }
        const int col0 = colt + wc * 32 + 8 * fq;
#pragma unroll
        for (int ai = 0; ai < 2; ++ai)
#pragma unroll
            for (int m = 0; m < 4; ++m) { bf16_t* rowp = base + (size_t)(row0 + ai * HALF + m * 16) * ldc + col0;
#pragma unroll
                for (int bj = 0; bj < 2; ++bj) { f32x4 v0 = acc[ai][bj][m][0], v1 = acc[ai][bj][m][1];
                    if (mode == 1) { f32x2 a = gelu_pk((f32x2){v0[0], v0[1]}), b = gelu_pk((f32x2){v0[2], v0[3]}), c = gelu_pk((f32x2){v1[0], v1[1]}), d = gelu_pk((f32x2){v1[2], v1[3]});
                        v0 = (f32x4){a.x, a.y, b.x, b.y}; v1 = (f32x4){c.x, c.y, d.x, d.y}; }
                    else if (mode == 2) {
#pragma unroll
                        for (int j = 0; j < 4; ++j) { v0[j] = fast_sigmoid(v0[j]); v1[j] = fast_sigmoid(v1[j]); } }
                    u32x4 w; w.x = cvt_pk_bf16(v0[0], v0[1]); w.y = cvt_pk_bf16(v0[2], v0[3]); w.z = cvt_pk_bf16(v1[0], v1[1]); w.w = cvt_pk_bf16(v1[2], v1[3]);
                    *(u32x4*)(rowp + bj * HALF) = w; } }
    }
};
struct EpiBf16 {
    bf16_t* O; int ldc; size_t pn_stride; int pn_per;
    __device__ __forceinline__ void operator()(const f32x4 (&acc)[2][2][4][2], const Unit& u, int wr, int wc, int fr, int fq) const {
        const int row0 = u.pm * BM + wr * 64 + fr; const int tsel = u.pn / pn_per; const int col0 = (u.pn - tsel * pn_per) * BM + wc * 32 + 8 * fq;
        bf16_t* base = O + (size_t)tsel * pn_stride;
#pragma unroll
        for (int ai = 0; ai < 2; ++ai)
#pragma unroll
            for (int m = 0; m < 4; ++m) { bf16_t* rowp = base + (size_t)(row0 + ai * HALF + m * 16) * ldc + col0;
#pragma unroll
                for (int bj = 0; bj < 2; ++bj) { const f32x4 v0 = acc[ai][bj][m][0], v1 = acc[ai][bj][m][1];
                    u32x4 w; w.x = cvt_pk_bf16(v0[0], v0[1]); w.y = cvt_pk_bf16(v0[2], v0[3]); w.z = cvt_pk_bf16(v1[0], v1[1]); w.w = cvt_pk_bf16(v1[2], v1[3]);
                    *(u32x4*)(rowp + bj * HALF) = w; } }
    }
};
struct EpiSwiGlu {
    bf16_t* O; int ldc;
    __device__ __forceinline__ void operator()(const f32x4 (&acc)[2][2][4][2], const Unit& u, int wr, int wc, int fr, int fq) const {
        const int row0 = u.pm * BM + wr * 64 + fr; const int col0 = u.pn * HALF + wc * 32 + 8 * fq;
#pragma unroll
        for (int ai = 0; ai < 2; ++ai)
#pragma unroll
            for (int m = 0; m < 4; ++m) { bf16_t* rowp = O + (size_t)(row0 + ai * HALF + m * 16) * ldc + col0;
                f32x4 o0, o1;
#pragma unroll
                for (int j = 0; j < 4; ++j) { const float g0 = acc[ai][0][m][0][j], g1 = acc[ai][0][m][1][j];
                    o0[j] = g0 * fast_sigmoid(g0) * acc[ai][1][m][0][j]; o1[j] = g1 * fast_sigmoid(g1) * acc[ai][1][m][1][j]; }
                u32x4 w; w.x = cvt_pk_bf16(o0[0], o0[1]); w.y = cvt_pk_bf16(o0[2], o0[3]); w.z = cvt_pk_bf16(o1[0], o1[1]); w.w = cvt_pk_bf16(o1[2], o1[3]);
                *(u32x4*)rowp = w; }
    }
};
struct EpiResidual {
    float* X; int ldc;
    __device__ __forceinline__ void operator()(const f32x4 (&acc)[2][2][4][2], const Unit& u, int wr, int wc, int fr, int fq) const {
        const int row0 = u.pm * BM + wr * 64 + fr; const int col0 = u.pn * BM + wc * 32 + 8 * fq;
#pragma unroll
        for (int ai = 0; ai < 2; ++ai)
#pragma unroll
            for (int m = 0; m < 4; ++m) { float* rowp = X + (size_t)(row0 + ai * HALF + m * 16) * ldc + col0;
#pragma unroll
                for (int bj = 0; bj < 2; ++bj) { f32x4* p = (f32x4*)(rowp + bj * HALF); const f32x4 x0 = p[0], x1 = p[1];
                    p[0] = x0 + acc[ai][bj][m][0]; p[1] = x1 + acc[ai][bj][m][1]; } }
    }
};

template <class Epi>
__device__ __forceinline__ void gemm_phase(LAS unsigned char* lds, const int K, const SegOrder& S, const Epi& E) {
    int tid_ = threadIdx.x; asm volatile("" : "+v"(tid_));
    const int tid = tid_, wid = __builtin_amdgcn_readfirstlane(tid >> 6), lane = tid & 63, wr = wid >> 2, wc = wid & 3, fr = lane & 15, fq = lane >> 4;
    const int nt = K / BK;
    unsigned voffA[2], voffB[2];
#pragma unroll
    for (int i = 0; i < 2; ++i) { int R, C; stage_rc(tid * 16 + i * 8192, R, C); const int Rb = (R & ~31) + perm32(R & 31);
        voffA[i] = (unsigned)(R * K + C) * 2u; voffB[i] = (unsigned)(Rb * K + C) * 2u; }
    const size_t kstep = (size_t)(BK * 2);
    const size_t hstep = (size_t)HALF * K * 2;
    const size_t tstep = 2 * hstep;
    const unsigned ldsw = (unsigned)wid * 1024u;
    const int aoff = lds_byte(wr * 64 + fr, fq * 8), boff = lds_byte(wc * 32 + fr, fq * 8);
#define PG8_SA(b, h) (((b) * 2 + (h)) * HTB)
#define PG8_SB(b, h) ((4 + (b) * 2 + (h)) * HTB)
#define PG8_STAGE(bufoff, gbase, voff) do { _Pragma("unroll") for (int _i = 0; _i < 2; ++_i) \
        __builtin_amdgcn_global_load_lds((const unsigned*)((const char*)(gbase) + (voff)[_i]), (LAS unsigned*)(lds + (bufoff) + ldsw + _i * 8192), 16, 0, 0); } while (0)
#define PG8_LDA(dst, b, h) do { _Pragma("unroll") for (int m = 0; m < 4; ++m) _Pragma("unroll") for (int k = 0; k < 2; ++k) dst[m][k] = *(const LAS bf16x8*)(lds + PG8_SA(b, h) + aoff + m * 2048 + k * 1024); } while (0)
#define PG8_LDB(dst, b, h) do { _Pragma("unroll") for (int n = 0; n < 2; ++n) _Pragma("unroll") for (int k = 0; k < 2; ++k) dst[n][k] = *(const LAS bf16x8*)(lds + PG8_SB(b, h) + boff + n * 2048 + k * 1024); } while (0)
#define PG8_MMA(ai, bj, At, Bt) do { __builtin_amdgcn_s_setprio(1); _Pragma("unroll") for (int m = 0; m < 4; ++m) _Pragma("unroll") for (int n = 0; n < 2; ++n) _Pragma("unroll") for (int k = 0; k < 2; ++k) \
        acc[ai][bj][m][n] = __builtin_amdgcn_mfma_f32_16x16x32_bf16(Bt[n][k], At[m][k], acc[ai][bj][m][n], 0, 0, 0); __builtin_amdgcn_s_setprio(0); } while (0)
#define PG8_WAIT_V(n) asm volatile("s_waitcnt vmcnt(" #n ")" ::: "memory")
#define PG8_WAIT_L(n) asm volatile("s_waitcnt lgkmcnt(" #n ")" ::: "memory")
#define PG8_BAR __builtin_amdgcn_s_barrier()
#define PG8_SCHED __builtin_amdgcn_sched_barrier(0)
    Unit cur, nxt; int ui = 0;
    if (!S.next(0, cur)) return;
    f32x4 acc[2][2][4][2];
#pragma unroll
    for (int a = 0; a < 2; ++a)
#pragma unroll
        for (int b = 0; b < 2; ++b)
#pragma unroll
            for (int m = 0; m < 4; ++m)
#pragma unroll
                for (int n = 0; n < 2; ++n) acc[a][b][m][n] = (f32x4){0.f, 0.f, 0.f, 0.f};
    bf16x8 At[4][2], B0[2][2], B1[2][2];
    const char* cA = S.abase(cur) + (size_t)cur.pm * tstep; const char* cB = S.bbase(cur) + (size_t)cur.pn * tstep;
    PG8_STAGE(PG8_SB(0, 0), cB, voffB); PG8_STAGE(PG8_SB(0, 1), cB + hstep, voffB); PG8_STAGE(PG8_SA(0, 0), cA, voffA); PG8_STAGE(PG8_SA(0, 1), cA + hstep, voffA);
    if (wr == 1) PG8_BAR;
    PG8_WAIT_V(2); PG8_BAR;
    PG8_STAGE(PG8_SB(1, 0), cB + kstep, voffB); PG8_STAGE(PG8_SA(1, 0), cA + kstep, voffA); PG8_STAGE(PG8_SB(1, 1), cB + hstep + kstep, voffB);
    PG8_WAIT_V(6); PG8_BAR;
    for (;;) {
        const bool has_next = S.next(ui + 1, nxt);
        const char* nA = has_next ? S.abase(nxt) + (size_t)nxt.pm * tstep : cA; const char* nB = has_next ? S.bbase(nxt) + (size_t)nxt.pn * tstep : cB;
        for (int t = 0; t < nt; t += 2) {
            const bool last = (t == nt - 2);
            const char* a1 = cA + (size_t)(t + 1) * kstep;
            const char* a2 = last ? nA : cA + (size_t)(t + 2) * kstep; const char* b2 = last ? nB : cB + (size_t)(t + 2) * kstep;
            const char* a3 = a2 + kstep; const char* b3 = b2 + kstep;
            PG8_LDB(B0, 0, 0); PG8_LDB(B1, 0, 1); PG8_SCHED; PG8_LDA(At, 0, 0); PG8_STAGE(PG8_SA(1, 1), a1 + hstep, voffA);
            PG8_WAIT_V(8); PG8_WAIT_L(0); PG8_BAR; PG8_MMA(0, 0, At, B0); PG8_MMA(0, 1, At, B1); PG8_BAR; PG8_SCHED;
            PG8_LDA(At, 0, 1); PG8_STAGE(PG8_SB(0, 0), b2, voffB); PG8_STAGE(PG8_SB(0, 1), b2 + hstep, voffB); PG8_STAGE(PG8_SA(0, 0), a2, voffA);
            PG8_WAIT_V(8); PG8_WAIT_L(0); PG8_BAR; PG8_MMA(1, 0, At, B0); PG8_MMA(1, 1, At, B1); PG8_BAR; PG8_SCHED;
            PG8_LDB(B0, 1, 0); PG8_LDB(B1, 1, 1); PG8_SCHED; PG8_LDA(At, 1, 0); PG8_STAGE(PG8_SA(0, 1), a2 + hstep, voffA);
            PG8_WAIT_V(8); PG8_WAIT_L(0); PG8_BAR; PG8_MMA(0, 0, At, B0); PG8_MMA(0, 1, At, B1); PG8_BAR; PG8_SCHED;
            PG8_LDA(At, 1, 1); PG8_STAGE(PG8_SB(1, 0), b3, voffB); PG8_STAGE(PG8_SB(1, 1), b3 + hstep, voffB); PG8_STAGE(PG8_SA(1, 0), a3, voffA);
            PG8_WAIT_V(8); PG8_WAIT_L(0); PG8_BAR; PG8_MMA(1, 0, At, B0); PG8_MMA(1, 1, At, B1); PG8_BAR; PG8_SCHED;
        }
        if (wr == 0) PG8_BAR;
        E(acc, cur, wr, wc, fr, fq);
        if (!has_next) break;
#pragma unroll
        for (int a = 0; a < 2; ++a)
#pragma unroll
            for (int b = 0; b < 2; ++b)
#pragma unroll
                for (int m = 0; m < 4; ++m)
#pragma unroll
                    for (int n = 0; n < 2; ++n) acc[a][b][m][n] = (f32x4){0.f, 0.f, 0.f, 0.f};
        cur = nxt; cA = nA; cB = nB; ++ui;
        if (wr == 1) PG8_BAR;
    }
    PG8_WAIT_V(0);
    PG8_BAR;
#undef PG8_SA
#undef PG8_SB
#undef PG8_STAGE
#undef PG8_LDA
#undef PG8_LDB
#undef PG8_MMA
#undef PG8_WAIT_V
#undef PG8_WAIT_L
#undef PG8_BAR
#undef PG8_SCHED
}
}

struct Args { const float* in[N_INPUTS]; float* out; unsigned char* ws; int ph_lo, ph_hi; };
constexpr int PTAB_OFF = LDS_MISC_OFF + 256;
struct PT {
    LAS unsigned char* lds;
    __device__ __forceinline__ unsigned long long raw(int i) const { const u32x2 v = *(const LAS u32x2*)(lds + PTAB_OFF + 8 * i);
        return ((unsigned long long)(unsigned)__builtin_amdgcn_readfirstlane((int)v.y) << 32) | (unsigned long long)(unsigned)__builtin_amdgcn_readfirstlane((int)v.x); }
    __device__ __forceinline__ const float* in(int i) const { return (const float*)raw(i); }
    __device__ __forceinline__ float* out() const { return (float*)raw(N_INPUTS); }
    __device__ __forceinline__ unsigned char* ws() const { return (unsigned char*)raw(N_INPUTS + 1); }
};

__device__ __forceinline__ void transpose_item(const float* W, int Nsrc, int k0, int n0, bf16_t* WT, int Kd, int drow0, LAS float* scr, int lane) {
#pragma unroll 8
    for (int i = 0; i < 32; ++i) { const int kk = 2 * i + (lane >> 5); scr[kk * 33 + (lane & 31)] = W[(size_t)(k0 + kk) * Nsrc + n0 + (lane & 31)]; }
    asm volatile("s_waitcnt lgkmcnt(0)" ::: "memory");
    const int c = lane & 7;
#pragma unroll
    for (int j = 0; j < 4; ++j) { const int n = (lane >> 3) + 8 * j; const LAS float* s = scr + (8 * c) * 33 + n;
        u32x4 o; o.x = pk2(s[0 * 33], s[1 * 33]); o.y = pk2(s[2 * 33], s[3 * 33]); o.z = pk2(s[4 * 33], s[5 * 33]); o.w = pk2(s[6 * 33], s[7 * 33]);
        *(u32x4*)(WT + (size_t)(drow0 + n) * Kd + k0 + 8 * c) = o; }
    asm volatile("s_waitcnt lgkmcnt(0)" ::: "memory");
}

constexpr int IT_WIN = 32 * 458, IT_BR = 16 * 64, IT_OUT = 32 * 64, IT_GU = 32 * 176, IT_DN = 88 * 64;
constexpr int IT_LAYER = IT_WIN + 3 * IT_BR + IT_OUT + 2 * IT_GU + IT_DN;

__device__ __forceinline__ void prologue_a(const PT& a, LAS unsigned char* lds) {
    unsigned char* ws = a.ws();
    const int tid = opaque_tid(), lane = tid & 63, wave = tid >> 6;
    const int gw = blockIdx.x * NWAVES + wave, NGW = gridDim.x * NWAVES;
    const size_t gt = (size_t)blockIdx.x * NTHREADS + tid, NGT = (size_t)gridDim.x * NTHREADS;
    { const f32x4* src = (const f32x4*)a.in(I_X); f32x4* dst = (f32x4*)(ws + WS_X);
      for (size_t i = gt; i < (size_t)M * D / 4; i += NGT) dst[i] = src[i]; }
    { for (int l = 0; l < DEPTH; ++l) { u32x4* p = (u32x4*)(ws + WS_WIN + l * WIN_L + (size_t)5440 * D * 2); const size_t n = (size_t)192 * D * 2 / 16;
        for (size_t i = gt; i < n; i += NGT) p[i] = (u32x4){0u, 0u, 0u, 0u}; } }
    LAS float* scr = (LAS float*)(lds + wave * 16384);
    for (int it = gw; it < DEPTH * IT_LAYER; it += NGW) {
        const int l = it / IT_LAYER; int r = it - l * IT_LAYER;
        if (r < IT_WIN) { const int kb = r / 458, nb = r % 458, n0 = nb * 32;
            int drow; if (n0 < 2048) drow = n0; else if (n0 < 5120) drow = NIN_MAIN + (n0 - 2048); else if (n0 < 8512) drow = 2048 + (n0 - 5120); else drow = 5632 + (n0 - 8512);
            transpose_item(a.in(I_W_IN) + (size_t)l * D * NIN, NIN, kb * 64, n0, (bf16_t*)(ws + WS_WIN + l * WIN_L), D, drow, scr, lane); continue; }
        r -= IT_WIN;
        if (r < 3 * IT_BR) { const int br = r / IT_BR; r -= br * IT_BR; const int kb = r / 64, nb = r % 64;
            const float* src = a.in(br == 0 ? I_W_BR_A : (br == 1 ? I_W_BR_B : I_W_BR_C)) + (size_t)l * 1024 * D;
            transpose_item(src, D, kb * 64, nb * 32, (bf16_t*)(ws + WS_WBR + l * WBR_L) + (size_t)br * D * 1024, 1024, nb * 32, scr, lane); continue; }
        r -= 3 * IT_BR;
        if (r < IT_OUT) { const int kb = r / 64, nb = r % 64;
            transpose_item(a.in(I_W_OUT) + (size_t)l * D * D, D, kb * 64, nb * 32, (bf16_t*)(ws + WS_WOUT + l * WOUT_L), D, nb * 32, scr, lane); continue; }
        r -= IT_OUT;
        if (r < 2 * IT_GU) { const int up = r / IT_GU; r -= up * IT_GU; const int kb = r / 176, nb = r % 176, n0 = nb * 32;
            const float* src = a.in(up ? I_W_FFN_UP : I_W_FFN_GATE) + (size_t)l * D * DFF;
            transpose_item(src, DFF, kb * 64, n0, (bf16_t*)(ws + WS_WGU + l * WGU_L), D, 256 * (n0 / 128) + (n0 % 128) + 128 * up, scr, lane); continue; }
        r -= 2 * IT_GU;
        { const int kb = r / 64, nb = r % 64;
            transpose_item(a.in(I_W_FFN_DOWN) + (size_t)l * DFF * D, D, kb * 64, nb * 32, (bf16_t*)(ws + WS_WDN + l * WDN_L), DFF, nb * 32, scr, lane); }
    }
    for (int row = gw; row < DEPTH * T; row += NGW) {
        const int l = row / T, t = row % T, j = lane;
        float f = 0.f;
        if (lane == 0) f = (float)t / (float)(T - 1);
        else if (lane < HYE) { const int m = (lane - 1) & 15; const float fr = 1e-4f + (float)m * ((15.0f - 1e-4f) / 15.0f);
            const float ang = (6.283185307179586f / (float)T) * (float)t * fr; f = (lane <= 16) ? cosf(ang) : -sinf(ang); }
        const float fq = a.in(I_HY_FREQ)[l * HYF + j];
        float acc = a.in(I_HY_B1)[l * HYF + j];
        { const float* w = a.in(I_HY_W1) + (size_t)l * HYE * HYF;
          for (int i = 0; i < HYE; ++i) acc += __shfl(f, i) * w[i * HYF + j]; }
        float z = sinf(fq * acc);
        acc = a.in(I_HY_B2)[l * HYF + j];
        { const float* w = a.in(I_HY_W2) + (size_t)l * HYF * HYF;
          for (int i = 0; i < HYF; ++i) acc += __shfl(z, i) * w[i * HYF + j]; }
        z = sinf(fq * acc);
        acc = a.in(I_HY_B3)[l * HYF + j];
        { const float* w = a.in(I_HY_W3) + (size_t)l * HYF * HYF;
          for (int i = 0; i < HYF; ++i) acc += __shfl(z, i) * w[i * HYF + j]; }
        z = sinf(fq * acc);
        ((float*)(ws + WS_Z3))[(size_t)row * HYF + j] = z;
    }
}

__device__ __forceinline__ void prologue_b(const PT& a, LAS unsigned char* lds) {
    unsigned char* ws = a.ws();
    const int tid = opaque_tid(), lane = tid & 63, wave = tid >> 6;
    LAS float* w4s = (LAS float*)lds;
    LAS float* dec = w4s + 1024;
    LAS float* red = dec + 16;
    LAS float* inv = red + 128;
    for (int u = blockIdx.x; u < DEPTH * 2 * 128; u += gridDim.x) {
        const int l = u >> 8, o = (u >> 7) & 1, c0 = (u & 127) * 8;
        __syncthreads();
        for (int e = tid; e < 1024; e += NTHREADS) { const int j = e >> 4, q = e & 15, dir = q >> 3, cl = q & 7;
            w4s[q * 64 + j] = a.in(I_HY_W4)[((size_t)l * HYF + j) * 4096 + dir * 2048 + o * 1024 + c0 + cl]; }
        if (tid < 16) { const int dir = tid >> 3, cl = tid & 7; dec[tid] = expf(a.in(I_HY_LOG_DECAY)[(((size_t)l * 2 + dir) * 2 + o) * 1024 + c0 + cl]); }
        __syncthreads();
        float* hf = (float*)(ws + WS_HF) + (((size_t)l * 2 + o) * 1024 + c0) * 4096;
        if (tid < 128) red[tid] = 0.f;
        __syncthreads();
#pragma unroll 1
        for (int i = 0; i < 4; ++i) {
            const int t = tid + NTHREADS * i; const float tn = (float)t / (float)(T - 1);
            f32x4 z[16]; const f32x4* zp = (const f32x4*)((const float*)(ws + WS_Z3) + ((size_t)l * T + t) * HYF);
#pragma unroll
            for (int j = 0; j < 16; ++j) z[j] = zp[j];
#pragma unroll 1
            for (int q = 0; q < 16; ++q) { const int dir = q >> 3, cl = q & 7; const LAS f32x4* wq = (const LAS f32x4*)(w4s + q * 64);
                float acc = 0.f;
#pragma unroll
                for (int j = 0; j < 16; ++j) { const f32x4 w = wq[j]; acc += z[j][0] * w[0]; acc += z[j][1] * w[1]; acc += z[j][2] * w[2]; acc += z[j][3] * w[3]; }
                const float h = acc * expf(-tn * dec[q]);
                const float s = wave_sum(fabsf(h));
                if (lane == 0) red[wave * 16 + q] += s;
                if (dir == 0) hf[(size_t)cl * 4096 + 2048 + t] = h; else if (t >= 1) hf[(size_t)cl * 4096 + 2048 - t] = h; }
        }
        __syncthreads();
        if (tid < 8) { float s = 0.f; for (int w = 0; w < 8; ++w) s += red[w * 16 + tid] + red[w * 16 + 8 + tid]; inv[tid] = 1.f / s; }
        __syncthreads();
        for (int i = 0; i < 4; ++i) {
            const int t = tid + NTHREADS * i;
#pragma unroll
            for (int cl = 0; cl < 8; ++cl) { const float s = inv[cl];
                hf[(size_t)cl * 4096 + 2048 + t] *= s; if (t >= 1) hf[(size_t)cl * 4096 + 2048 - t] *= s; }
        }
        if (tid < 8) hf[(size_t)tid * 4096] = 0.f;
    }
}

__device__ __forceinline__ void rmsnorm_phase(const float* X, const float* g, bf16_t* Hb, float* Of) {
    const int tid = opaque_tid(), lane = tid & 63, wave = tid >> 6;
    const int gw = blockIdx.x * NWAVES + wave, NGW = gridDim.x * NWAVES;
    for (int m = gw; m < M; m += NGW) {
        const f32x4* xr = (const f32x4*)(X + (size_t)m * D) + lane;
        f32x4 v[8]; float s = 0.f;
#pragma unroll
        for (int j = 0; j < 8; ++j) { v[j] = xr[64 * j]; s += (v[j][0] * v[j][0] + v[j][1] * v[j][1]) + (v[j][2] * v[j][2] + v[j][3] * v[j][3]); }
        const float rstd = 1.f / sqrtf(wave_sum(s) * (1.f / D) + RMS_EPS);
#pragma unroll
        for (int j = 0; j < 8; ++j) { const f32x4 gv = ((const f32x4*)g)[lane + 64 * j]; const f32x4 y = v[j] * rstd * gv;
            if (Of) ((f32x4*)(Of + (size_t)m * D))[lane + 64 * j] = y;
            else { u32x2 o; o.x = pk2(y[0], y[1]); o.y = pk2(y[2], y[3]); ((u32x2*)(Hb + (size_t)m * D))[lane + 64 * j] = o; } }
    }
}

__device__ __forceinline__ void gmlp_stats_phase(const bf16_t* PA, float* stats) {
    const int tid = opaque_tid(), lane = tid & 63, wave = tid >> 6;
    const int gw = blockIdx.x * NWAVES + wave, NGW = gridDim.x * NWAVES;
    for (int m = gw; m < M; m += NGW) {
        const u32x4* p = (const u32x4*)(PA + (size_t)m * 2048 + 1024) + lane * 2;
        const u32x4 a = p[0], b = p[1];
        float v[16];
#pragma unroll
        for (int j = 0; j < 4; ++j) { v[2 * j] = bflo(a[j]); v[2 * j + 1] = bfhi(a[j]); v[8 + 2 * j] = bflo(b[j]); v[8 + 2 * j + 1] = bfhi(b[j]); }
        float s = 0.f;
#pragma unroll
        for (int j = 0; j < 16; ++j) s += v[j];
        const float mu = wave_sum(s) * (1.f / 1024.f); float s2 = 0.f;
#pragma unroll
        for (int j = 0; j < 16; ++j) { const float d = v[j] - mu; s2 += d * d; }
        const float rstd = 1.f / sqrtf(wave_sum(s2) * (1.f / 1024.f) + LN_EPS);
        if (lane == 0) { stats[2 * m] = mu; stats[2 * m + 1] = rstd; }
    }
}

__device__ __forceinline__ void gmlp_unit(const PT& a, int l, int u, LAS unsigned char* lds) {
    unsigned char* ws = a.ws();
    const int tid = opaque_tid();
    const int g = u & 7, ck = u >> 3;
    const int tok0 = ck * CHUNK;
    LAS float* vn = (LAS float*)lds;
    LAS float* wsT = vn + 128 * 128;
    const bf16_t* PA = (const bf16_t*)(ws + WS_PA); const float* stats = (const float*)(ws + WS_STATS);
    const float* lng = a.in(I_GM_LN_G) + l * AW + g * 128; const float* lnb = a.in(I_GM_LN_B) + l * AW + g * 128;
    __syncthreads();
    for (int e = tid; e < 128 * 128; e += NTHREADS) { const int q = e >> 7, d = e & 127;
        const float x = bf2f(PA[(size_t)(tok0 + q) * 2048 + 1024 + g * 128 + d]);
        vn[e] = (x - stats[2 * (tok0 + q)]) * stats[2 * (tok0 + q) + 1] * lng[d] + lnb[d]; }
    { const float* wsrc = a.in(I_GM_WS) + ((size_t)l * AG + g) * 128 * 128;
      for (int e = tid; e < 128 * 128; e += NTHREADS) { const int p = e >> 7, q = e & 127; wsT[q * 128 + p] = wsrc[e]; } }
    __syncthreads();
    const int dg = tid & 31, pg = tid >> 5;
    float acc[8][4];
#pragma unroll
    for (int i = 0; i < 8; ++i)
#pragma unroll
        for (int j = 0; j < 4; ++j) acc[i][j] = 0.f;
    for (int q = 0; q < 128; ++q) {
        const f32x4 vv = *(const LAS f32x4*)(vn + q * 128 + 4 * dg);
        const f32x4 w0 = *(const LAS f32x4*)(wsT + q * 128 + 8 * pg), w1 = *(const LAS f32x4*)(wsT + q * 128 + 8 * pg + 4);
#pragma unroll
        for (int j = 0; j < 4; ++j) {
#pragma unroll
            for (int i = 0; i < 4; ++i) { acc[i][j] += w0[i] * vv[j]; acc[4 + i][j] += w1[i] * vv[j]; } }
    }
    const float* bs = a.in(I_GM_BS) + ((size_t)l * AG + g) * 128;
    bf16_t* YA = (bf16_t*)(ws + WS_YA);
#pragma unroll
    for (int i = 0; i < 8; ++i) { const int p = 8 * pg + i; const float bb = bs[p];
        const u32x2 uu = *(const u32x2*)(PA + (size_t)(tok0 + p) * 2048 + g * 128 + 4 * dg);
        const float y0 = bflo(uu.x) * (acc[i][0] + bb), y1 = bfhi(uu.x) * (acc[i][1] + bb), y2 = bflo(uu.y) * (acc[i][2] + bb), y3 = bfhi(uu.y) * (acc[i][3] + bb);
        u32x2 o; o.x = pk2(y0, y1); o.y = pk2(y2, y3);
        *(u32x2*)(YA + (size_t)(tok0 + p) * 1024 + g * 128 + 4 * dg) = o; }
}

__device__ __forceinline__ float hy_cv(const bf16_t* row, int t, float w0, float w1, float w2, float cb) {
    const float c = bf2f(row[t]); const float p = t > 0 ? bf2f(row[t - 1]) : 0.f; const float n = t < T - 1 ? bf2f(row[t + 1]) : 0.f;
    return w0 * p + w1 * c + w2 * n + cb;
}
__device__ __forceinline__ void hyena_unit(const PT& a, int l, int c, LAS unsigned char* lds) {
    unsigned char* ws = a.ws();
    const int tid = opaque_tid();
    LAS float* taps = (LAS float*)lds;
    LAS float* zin = taps + 4096;
    const bf16_t* PB = (const bf16_t*)(ws + WS_PB);
    const float* cw = a.in(I_HY_CONV_W) + (size_t)l * 3 * 3072; const float* cb = a.in(I_HY_CONV_B) + (size_t)l * 3072;
    const float* hf = (const float*)(ws + WS_HF) + (((size_t)l * 2 + 0) * 1024 + c) * 4096;
    const float bd0 = a.in(I_HY_BIAS_D)[(l * 2 + 0) * 1024 + c], bd1 = a.in(I_HY_BIAS_D)[(l * 2 + 1) * 1024 + c];
    __syncthreads();
    for (int e = tid; e < 4096; e += NTHREADS) taps[e] = hf[e];
    { const int ch = 2048 + c; const float w0 = cw[ch], w1 = cw[3072 + ch], w2 = cw[2 * 3072 + ch], b0 = cb[ch];
      for (int e = tid; e < T * 4; e += NTHREADS) { const int b = e >> 11, t = e & (T - 1); zin[t * 4 + b] = hy_cv(PB + (size_t)ch * M + b * T, t, w0, w1, w2, b0); } }
    __syncthreads();
    float acc[4][4];
#pragma unroll
    for (int order = 0; order < 2; ++order) {
#pragma unroll
        for (int i = 0; i < 4; ++i)
#pragma unroll
            for (int b = 0; b < 4; ++b) acc[i][b] = 0.f;
        for (int s = 0; s < T; ++s) {
            const f32x4 zv = *(const LAS f32x4*)(zin + s * 4);
#pragma unroll
            for (int i = 0; i < 4; ++i) { const float k = taps[tid + NTHREADS * i - s + 2048];
#pragma unroll
                for (int b = 0; b < 4; ++b) acc[i][b] += k * zv[b]; }
        }
        const float bd = order == 0 ? bd0 : bd1;
#pragma unroll
        for (int i = 0; i < 4; ++i) { const f32x4 zv = *(const LAS f32x4*)(zin + (tid + NTHREADS * i) * 4);
#pragma unroll
            for (int b = 0; b < 4; ++b) acc[i][b] += bd * zv[b]; }
        __syncthreads();
        const int ch = order == 0 ? c : 1024 + c;
        const float w0 = cw[ch], w1 = cw[3072 + ch], w2 = cw[2 * 3072 + ch], b0 = cb[ch];
        if (order == 0) {
#pragma unroll
            for (int i = 0; i < 4; ++i) { const int t = tid + NTHREADS * i; f32x4 o;
#pragma unroll
                for (int b = 0; b < 4; ++b) o[b] = acc[i][b] * hy_cv(PB + (size_t)ch * M + b * T, t, w0, w1, w2, b0);
                *(LAS f32x4*)(zin + t * 4) = o; }
            for (int e = tid; e < 4096; e += NTHREADS) taps[e] = hf[(size_t)1024 * 4096 + e];
            __syncthreads();
        } else {
            bf16_t* YB = (bf16_t*)(ws + WS_YB);
#pragma unroll
            for (int i = 0; i < 4; ++i) { const int t = tid + NTHREADS * i;
#pragma unroll
                for (int b = 0; b < 4; ++b) YB[(size_t)(b * T + t) * 1024 + c] = (bf16_t)f2bf(acc[i][b] * hy_cv(PB + (size_t)ch * M + b * T, t, w0, w1, w2, b0)); }
        }
    }
}

__device__ __forceinline__ float softplusf_(float x) { return fmaxf(x, 0.f) + log1pf(expf(-fabsf(x))); }
__device__ __forceinline__ float rw_mix(const bf16_t* PC, int tok, int x, float mp, float mn) {
    const int t = tok & (T - 1);
    const float c = bf2f(PC[(size_t)tok * CINP + x]);
    const float p = t > 0 ? bf2f(PC[(size_t)(tok - 1) * CINP + x]) : 0.f;
    const float n = t < T - 1 ? bf2f(PC[(size_t)(tok + 1) * CINP + x]) : 0.f;
    return c + mp * (p - c) + mn * (n - c);
}
__device__ __forceinline__ void rwkv_prep_unit(const PT& a, int l, int u, LAS unsigned char* lds) {
    unsigned char* ws = a.ws();
    const int tid = opaque_tid();
    const int tok0 = u * 8;
    const bf16_t* PC = (const bf16_t*)(ws + WS_PC);
    const float* mup = a.in(I_RW_MU_PREV) + (size_t)l * CIN; const float* mun = a.in(I_RW_MU_NEXT) + (size_t)l * CIN;
    LAS float* sg = (LAS float*)lds;
    LAS float* tw = sg + 8 * 128;
    LAS float* ad = tw + 8 * 96;
    LAS float* vv1 = ad + 8 * 96;
    LAS float* vmx = vv1 + 8 * 32;
    __syncthreads();
    for (int e = tid; e < 8 * 320; e += NTHREADS) { const int j = e / 320, xx = e - j * 320, x = 3072 + xx;
        const float c = rw_mix(PC, tok0 + j, x, mup[x], mun[x]);
        if (xx < 128) sg[j * 128 + xx] = sigmoidf_(c); else if (xx < 224) tw[j * 96 + (xx - 128)] = tanhf(c); else ad[j * 96 + (xx - 224)] = c; }
    if (l > 0) {
        for (int e = tid; e < 8 * 1024; e += NTHREADS) { const int j = e >> 10, ch = e & 1023; vmx[e] = rw_mix(PC, tok0 + j, 2048 + ch, mup[2048 + ch], mun[2048 + ch]); }
        __syncthreads();
        if (tid < 256) { const int j = tid >> 5, r = tid & 31; const float* v1 = a.in(I_RW_V1) + (size_t)(l - 1) * 1024 * VL; float acc = 0.f;
            for (int c = 0; c < 1024; ++c) acc += vmx[j * 1024 + c] * v1[c * VL + r];
            vv1[j * 32 + r] = acc; }
    }
    __syncthreads();
    float *Rb = (float*)(ws + WS_R), *Vb = (float*)(ws + WS_V), *Ab = (float*)(ws + WS_AA), *Wb = (float*)(ws + WS_WD), *Kb = (float*)(ws + WS_KD), *Bb = (float*)(ws + WS_BD),
          *Gb = (float*)(ws + WS_GG), *VF = (float*)(ws + WS_VFIRST);
#pragma unroll 1
    for (int half = 0; half < 2; ++half) {
        const int ch = tid + NTHREADS * half;
        float accw[2][8], acca[2][8], accg[8], accv[8];
#pragma unroll
        for (int j = 0; j < 8; ++j) { accw[0][j] = accw[1][j] = acca[0][j] = acca[1][j] = accg[j] = accv[j] = 0.f; }
        { const float* w2 = a.in(I_RW_W2) + (size_t)l * 2 * WL * 1024; const float* a2 = a.in(I_RW_A2) + (size_t)l * 2 * AL * 1024;
#pragma unroll
          for (int d = 0; d < 2; ++d)
            for (int r = 0; r < 48; ++r) { const float ww = w2[(size_t)(d * 48 + r) * 1024 + ch], wa = a2[(size_t)(d * 48 + r) * 1024 + ch];
#pragma unroll
                for (int j = 0; j < 8; ++j) { accw[d][j] += tw[j * 96 + d * 48 + r] * ww; acca[d][j] += ad[j * 96 + d * 48 + r] * wa; } } }
        { const float* g2 = a.in(I_RW_G2) + (size_t)l * GL * 1024;
          for (int r = 0; r < GL; ++r) { const float w = g2[(size_t)r * 1024 + ch];
#pragma unroll
              for (int j = 0; j < 8; ++j) accg[j] += sg[j * 128 + r] * w; } }
        if (l > 0) { const float* v2 = a.in(I_RW_V2) + (size_t)(l - 1) * VL * 1024;
          for (int r = 0; r < VL; ++r) { const float w = v2[(size_t)r * 1024 + ch];
#pragma unroll
              for (int j = 0; j < 8; ++j) accv[j] += vv1[j * 32 + r] * w; } }
        const float w00 = a.in(I_RW_W0)[(l * 2 + 0) * 1024 + ch], w01 = a.in(I_RW_W0)[(l * 2 + 1) * 1024 + ch];
        const float a00 = a.in(I_RW_A0)[(l * 2 + 0) * 1024 + ch], a01 = a.in(I_RW_A0)[(l * 2 + 1) * 1024 + ch];
        const float kkw = a.in(I_RW_K_K)[l * 1024 + ch], kaw = a.in(I_RW_K_A)[l * 1024 + ch];
        const float v0w = l > 0 ? a.in(I_RW_V0)[(l - 1) * 1024 + ch] : 0.f;
        const float mpr = mup[ch], mnr = mun[ch], mpk = mup[1024 + ch], mnk = mun[1024 + ch], mpv = mup[2048 + ch], mnv = mun[2048 + ch];
#pragma unroll
        for (int j = 0; j < 8; ++j) {
            const int tok = tok0 + j; const size_t o = (size_t)tok * 1024 + ch;
            const float r = rw_mix(PC, tok, ch, mpr, mnr), k = rw_mix(PC, tok, 1024 + ch, mpk, mnk);
            float v;
            if (l == 0) { v = rw_mix(PC, tok, 2048 + ch, mpv, mnv); VF[o] = v; }
            else { v = vmx[j * 1024 + ch]; v = v + (VF[o] - v) * sigmoidf_(v0w + accv[j]); }
            float kk = k * kkw; const float ss = wave_sum(kk * kk); kk = kk / fmaxf(sqrtf(ss), 1e-12f);
            Rb[o] = r; Vb[o] = v; Ab[o] = -kk; Gb[o] = accg[j];
#pragma unroll
            for (int d = 0; d < 2; ++d) {
                const float wl = -softplusf_(-((d ? w01 : w00) + accw[d][j])) - 0.5f;
                const float decay = expf(-expf(wl));
                const float aa = sigmoidf_((d ? a01 : a00) + acca[d][j]);
                const size_t od = (size_t)d * M * 1024 + o;
                Wb[od] = decay; Kb[od] = k * (1.f + (aa - 1.f) * kaw); Bb[od] = kk * aa;
            }
        }
    }
}

struct ScanIn { f32x4 a0, a1, w0, w1, b0, b1, k0, k1, r0, r1; float v; };
__device__ __forceinline__ void scan_load(ScanIn& s, const float* Ab, const float* Wb, const float* Bb, const float* Kb, const float* Rb, const float* Vb, size_t base, int cg, int row) {
    const size_t o = base + cg * 8;
    s.a0 = *(const f32x4*)(Ab + o); s.a1 = *(const f32x4*)(Ab + o + 4); s.w0 = *(const f32x4*)(Wb + o); s.w1 = *(const f32x4*)(Wb + o + 4);
    s.b0 = *(const f32x4*)(Bb + o); s.b1 = *(const f32x4*)(Bb + o + 4); s.k0 = *(const f32x4*)(Kb + o); s.k1 = *(const f32x4*)(Kb + o + 4);
    s.r0 = *(const f32x4*)(Rb + o); s.r1 = *(const f32x4*)(Rb + o + 4); s.v = Vb[base + row];
}
__device__ __forceinline__ float red8(float v) { v += __shfl_xor(v, 1); v += __shfl_xor(v, 2); v += __shfl_xor(v, 4); return v; }
__device__ __forceinline__ void wkv_scan_seq(const PT& a, int seq) {
    unsigned char* ws = a.ws();
    const int tid = opaque_tid(), lane = tid & 63, wave = tid >> 6;
    const int dir = seq >> 6, b = (seq >> 4) & 3, h = seq & 15;
    const int cg = lane & 7, row = wave * 8 + (lane >> 3);
    const float *Rb = (const float*)(ws + WS_R), *Vb = (const float*)(ws + WS_V), *Ab = (const float*)(ws + WS_AA);
    const float *Wb = (const float*)(ws + WS_WD) + (size_t)dir * M * 1024, *Kb = (const float*)(ws + WS_KD) + (size_t)dir * M * 1024, *Bb = (const float*)(ws + WS_BD) + (size_t)dir * M * 1024;
    float* Y = (float*)(ws + WS_YS) + (size_t)dir * M * 1024;
    f32x4 S0 = {0.f, 0.f, 0.f, 0.f}, S1 = {0.f, 0.f, 0.f, 0.f};
    ScanIn cur, nxt;
    { const int tt = dir ? T - 1 : 0; scan_load(cur, Ab, Wb, Bb, Kb, Rb, Vb, (size_t)(b * T + tt) * 1024 + h * 64, cg, row); }
    for (int step = 0; step < T; ++step) {
        const int tt = dir ? T - 1 - step : step;
        const int sn = step + 1 < T ? step + 1 : step; const int tn = dir ? T - 1 - sn : sn;
        scan_load(nxt, Ab, Wb, Bb, Kb, Rb, Vb, (size_t)(b * T + tn) * 1024 + h * 64, cg, row);
        float sa = S0[0] * cur.a0[0] + S0[1] * cur.a0[1] + S0[2] * cur.a0[2] + S0[3] * cur.a0[3] + S1[0] * cur.a1[0] + S1[1] * cur.a1[1] + S1[2] * cur.a1[2] + S1[3] * cur.a1[3];
        sa = red8(sa);
        S0 = S0 * cur.w0 + sa * cur.b0 + cur.v * cur.k0;
        S1 = S1 * cur.w1 + sa * cur.b1 + cur.v * cur.k1;
        float y = S0[0] * cur.r0[0] + S0[1] * cur.r0[1] + S0[2] * cur.r0[2] + S0[3] * cur.r0[3] + S1[0] * cur.r1[0] + S1[1] * cur.r1[1] + S1[2] * cur.r1[2] + S1[3] * cur.r1[3];
        y = red8(y);
        if (cg == 0) Y[(size_t)(b * T + tt) * 1024 + h * 64 + row] = y;
        cur = nxt;
    }
}

__device__ __forceinline__ void rwkv_post_phase(const PT& a, int l) {
    unsigned char* ws = a.ws();
    const int tid = opaque_tid();
    const float *Rb = (const float*)(ws + WS_R), *Vb = (const float*)(ws + WS_V), *Kb = (const float*)(ws + WS_KD), *Gb = (const float*)(ws + WS_GG), *Y = (const float*)(ws + WS_YS);
    bf16_t* YC = (bf16_t*)(ws + WS_YC);
    for (int tok = blockIdx.x; tok < M; tok += gridDim.x) {
#pragma unroll
        for (int half = 0; half < 2; ++half) {
            const int ch = tid + NTHREADS * half; const size_t o = (size_t)tok * 1024 + ch;
            const float y = Y[o] + Y[(size_t)M * 1024 + o];
            const float mu = wave_sum(y) * (1.f / 64.f); const float d = y - mu; const float var = wave_sum(d * d) * (1.f / 64.f);
            const float yn = d * (1.f / sqrtf(var + GN_EPS)) * a.in(I_RW_LN_G)[l * 1024 + ch] + a.in(I_RW_LN_B)[l * 1024 + ch];
            const float r = Rb[o]; const float bon = wave_sum(r * (Kb[o] + Kb[(size_t)M * 1024 + o]) * a.in(I_RW_R_K)[l * 1024 + ch]);
            const float out = (yn + bon * Vb[o]) * Gb[o];
            YC[o] = (bf16_t)f2bf(out);
        }
    }
}

__device__ __forceinline__ void merge_phase(const PT& a) {
    unsigned char* ws = a.ws();
    const size_t gt = (size_t)blockIdx.x * NTHREADS + opaque_tid(), NGT = (size_t)gridDim.x * NTHREADS;
    const bf16_t* PG = (const bf16_t*)(ws + WS_PG); const bf16_t* PBR = (const bf16_t*)(ws + WS_PBR); bf16_t* MG = (bf16_t*)(ws + WS_MERGED);
    for (size_t i = gt; i < (size_t)M * D / 8; i += NGT) {
        const size_t m = i / (D / 8), c = (i % (D / 8)) * 8;
        float acc[8];
#pragma unroll
        for (int j = 0; j < 8; ++j) acc[j] = 0.f;
#pragma unroll
        for (int br = 0; br < 3; ++br) {
            const u32x4 g = *(const u32x4*)(PG + m * 6144 + br * 2048 + c); const u32x4 p = *(const u32x4*)(PBR + ((size_t)br * M + m) * D + c);
#pragma unroll
            for (int j = 0; j < 4; ++j) { acc[2 * j] += bflo(g[j]) * bflo(p[j]); acc[2 * j + 1] += bfhi(g[j]) * bfhi(p[j]); }
        }
        u32x4 o; o.x = pk2(acc[0], acc[1]); o.y = pk2(acc[2], acc[3]); o.z = pk2(acc[4], acc[5]); o.w = pk2(acc[6], acc[7]);
        *(u32x4*)(MG + m * D + c) = o;
    }
}

constexpr int PH_PRO_A = 0, PH_PRO_B = 1, PH_LAYER0 = 2, PH_PER_LAYER = 11, PH_FINAL = PH_LAYER0 + DEPTH * PH_PER_LAYER, N_PHASES = PH_FINAL + 1;

__global__ void __launch_bounds__(NTHREADS, 2) mk_fwd(Args args) {
    extern __shared__ __attribute__((aligned(16))) unsigned char lds_raw[];
    LAS unsigned char* lds = (LAS unsigned char*)lds_raw;
    const int tid = threadIdx.x;
    volatile LAS unsigned* misc = (volatile LAS unsigned*)(lds + LDS_MISC_OFF);
    if (tid < 64) misc[tid] = 0u;
    if (tid < 64) {   LAS unsigned long long* tab = (LAS unsigned long long*)(lds + PTAB_OFF);
        unsigned long long v = 0ull;
#pragma unroll
        for (int i = 0; i < N_INPUTS; ++i) v = (tid == i) ? (unsigned long long)args.in[i] : v;
        v = (tid == N_INPUTS) ? (unsigned long long)args.out : v;
        v = (tid == N_INPUTS + 1) ? (unsigned long long)args.ws : v;
        tab[tid] = v; }
    __syncthreads();
    const PT pt{lds};
    XcdBarrier bar = xcd_barrier_post((unsigned*)(pt.ws() + WS_CTL) + CW_BAR, misc + 8);
    const int lo = args.ph_lo, hi = args.ph_hi;
    const int G = gridDim.x, bid = blockIdx.x;
#define IN(k) (lo <= (k) && (k) < hi)
#define SEAM(k) do { if ((k) + 1 < hi) xcd_barrier(bar); } while (0)

    if (IN(PH_PRO_A)) { prologue_a(pt, lds); SEAM(PH_PRO_A); }
    if (IN(PH_PRO_B)) { prologue_b(pt, lds); SEAM(PH_PRO_B); }

#pragma unroll 1
    for (int l = 0; l < DEPTH; ++l) {
        const int p0 = PH_LAYER0 + l * PH_PER_LAYER;
        unsigned char* ws = pt.ws();
        float* X = (float*)(ws + WS_X); bf16_t* Hb = (bf16_t*)(ws + WS_H);
        if (IN(p0 + 0)) { rmsnorm_phase(X, pt.in(I_NORM_MIX_G) + l * D, Hb, nullptr); SEAM(p0 + 0); }
        if (IN(p0 + 1)) {
            const bf16_t* W = (const bf16_t*)(ws + WS_WIN + l * WIN_L);
            pg8::SegOrder S{Hb, W, M / 256, NIN_MAIN / 256, W + (size_t)NIN_MAIN * D, Hb, 3 * BW / 256, M / 256, G, bid};
            pg8::EpiInProj E{(bf16_t*)(ws + WS_PA), (bf16_t*)(ws + WS_PC), (bf16_t*)(ws + WS_PG), (bf16_t*)(ws + WS_PB)};
            pg8::gemm_phase<pg8::EpiInProj>(lds, D, S, E);
            SEAM(p0 + 1);
        }
        if (IN(p0 + 2)) {
            gmlp_stats_phase((const bf16_t*)(ws + WS_PA), (float*)(ws + WS_STATS));
            for (int u = bid; u < M / 8; u += G) rwkv_prep_unit(pt, l, u, lds);
            for (int c = bid; c < BW; c += G) hyena_unit(pt, l, c, lds);
            SEAM(p0 + 2);
        }
        if (IN(p0 + 3)) {
            for (int s = bid; s < 128; s += G) wkv_scan_seq(pt, s);
            if (G > 128) { if (bid >= 128) for (int u = bid - 128; u < 512; u += G - 128) gmlp_unit(pt, l, u, lds); }
            else { for (int u = bid; u < 512; u += G) gmlp_unit(pt, l, u, lds); }
            SEAM(p0 + 3);
        }
        if (IN(p0 + 4)) { rwkv_post_phase(pt, l); SEAM(p0 + 4); }
        if (IN(p0 + 5)) {
            const bf16_t* W = (const bf16_t*)(ws + WS_WBR + l * WBR_L);
#pragma unroll 1
            for (int br = 0; br < 3; ++br) {
                const bf16_t* Y = (const bf16_t*)(ws + (br == 0 ? WS_YA : (br == 1 ? WS_YB : WS_YC)));
                pg8::SegOrder S{Y, W + (size_t)br * D * 1024, M / 256, D / 256, Y, W, 0, 0, G, bid};
                pg8::EpiBf16 E{(bf16_t*)(ws + WS_PBR) + (size_t)br * M * D, D, 0, 8};
                pg8::gemm_phase<pg8::EpiBf16>(lds, 1024, S, E);
            }
            SEAM(p0 + 5);
        }
        if (IN(p0 + 6)) { merge_phase(pt); SEAM(p0 + 6); }
        if (IN(p0 + 7)) {
            const bf16_t* Mg = (const bf16_t*)(ws + WS_MERGED); const bf16_t* W = (const bf16_t*)(ws + WS_WOUT + l * WOUT_L);
            pg8::SegOrder S{Mg, W, M / 256, D / 256, Mg, W, 0, 0, G, bid};
            pg8::EpiResidual E{X, D};
            pg8::gemm_phase<pg8::EpiResidual>(lds, D, S, E);
            SEAM(p0 + 7);
        }
        if (IN(p0 + 8)) { rmsnorm_phase(X, pt.in(I_NORM_FFN_G) + l * D, Hb, nullptr); SEAM(p0 + 8); }
        if (IN(p0 + 9)) {
            const bf16_t* W = (const bf16_t*)(ws + WS_WGU + l * WGU_L);
            pg8::SegOrder S{Hb, W, M / 256, 2 * DFF / 256, Hb, W, 0, 0, G, bid};
            pg8::EpiSwiGlu E{(bf16_t*)(ws + WS_ACT), DFF};
            pg8::gemm_phase<pg8::EpiSwiGlu>(lds, D, S, E);
            SEAM(p0 + 9);
        }
        if (IN(p0 + 10)) {
            const bf16_t* Ac = (const bf16_t*)(ws + WS_ACT); const bf16_t* W = (const bf16_t*)(ws + WS_WDN + l * WDN_L);
            pg8::SegOrder S{Ac, W, M / 256, D / 256, Ac, W, 0, 0, G, bid};
            pg8::EpiResidual E{X, D};
            pg8::gemm_phase<pg8::EpiResidual>(lds, DFF, S, E);
            SEAM(p0 + 10);
        }
    }
    if (IN(PH_FINAL)) rmsnorm_phase((const float*)(pt.ws() + WS_X), pt.in(I_NORM_FINAL_G), nullptr, pt.out());
#undef IN
#undef SEAM
}

extern "C" void kernel_launch(void* const* d_in, const int* in_sizes, int n_in, void* d_out, int out_size, void* d_ws, size_t ws_size, hipStream_t stream) {
    static int grid = 0;
    if (grid == 0) {
        if (n_in != N_INPUTS || out_size != M * D || ws_size < WS_END) { fprintf(stderr, "kernel_launch: unexpected shapes: n_in %d out %d ws %zu (need %zu)\n", n_in, out_size, ws_size, (size_t)WS_END); grid = -1; return; }
        int dev = 0, cus = 0, per_cu = 0;
        if (hipGetDevice(&dev) != hipSuccess || hipDeviceGetAttribute(&cus, hipDeviceAttributeMultiprocessorCount, dev) != hipSuccess) { grid = -1; return; }
        if (hipFuncSetAttribute((const void*)mk_fwd, hipFuncAttributeMaxDynamicSharedMemorySize, LDS_BYTES) != hipSuccess) { fprintf(stderr, "kernel_launch: hipFuncSetAttribute failed\n"); grid = -1; return; }
        if (hipOccupancyMaxActiveBlocksPerMultiprocessor(&per_cu, (const void*)mk_fwd, NTHREADS, LDS_BYTES) != hipSuccess || per_cu < 1) { fprintf(stderr, "kernel_launch: occupancy query says %d\n", per_cu); (void)hipGetLastError(); grid = -1; return; }
        grid = cus;
    }
    if (grid < 0) return;
    (void)hipMemsetAsync((char*)d_ws + WS_CTL, 0, CTL_ZERO_BYTES, stream);
    Args a{};
    for (int i = 0; i < N_INPUTS; ++i) a.in[i] = (const float*)d_in[i];
    a.out = (float*)d_out; a.ws = (unsigned char*)d_ws;
#if MK_LAUNCH_PER_PHASE
    for (int p = 0; p < N_PHASES; ++p) { a.ph_lo = p; a.ph_hi = p + 1; hipLaunchKernelGGL(mk_fwd, dim3(grid), dim3(NTHREADS), LDS_BYTES, stream, a); }
#else
    a.ph_lo = 0; a.ph_hi = N_PHASES;
    hipLaunchKernelGGL(mk_fwd, dim3(grid), dim3(NTHREADS), LDS_BYTES, stream, a);
#endif
}
```

```cpp
#include <hip/hip_runtime.h>
#include <cstdio>
#include <cstdint>

#ifndef MK_LAUNCH_PER_PHASE
#define MK_LAUNCH_PER_PHASE 0
#endif

#define GAS __attribute__((address_space(1)))
#define LAS __attribute__((address_space(3)))
typedef unsigned short bf16_t;
typedef short bf16x8 __attribute__((ext_vector_type(8)));
typedef float f32x4 __attribute__((ext_vector_type(4)));
typedef float f32x2 __attribute__((ext_vector_type(2)));
typedef unsigned u32x4 __attribute__((ext_vector_type(4)));
typedef unsigned u32x2 __attribute__((ext_vector_type(2)));

constexpr int NB = 4, T = 2048, M = NB * T, D = 2048, DEPTH = 4;
constexpr int AW = 1024, AG = 8, CHUNK = 128;
constexpr int BW = 1024;
constexpr int CW = 1024, CH = 16, CN = 64, WL = 48, AL = 48, VL = 32, GL = 128;
constexpr int CIN = 3 * CW + GL + 2 * WL + 2 * AL;
constexpr int CINP = 3584;
constexpr int NIN = 2 * AW + 3 * BW + CIN + 3 * D;
constexpr int DFF = 5632;
constexpr int HYF = 64, HYE = 33;
constexpr float RMS_EPS = 1e-6f, LN_EPS = 1e-5f, GN_EPS = 64e-5f;
constexpr int NIN_MAIN = 2 * AW + CINP + 3 * D;
constexpr int NINP = NIN_MAIN + 3 * BW;

enum { I_X = 0, I_NORM_MIX_G, I_W_IN, I_GM_LN_G, I_GM_LN_B, I_GM_WS, I_GM_BS, I_HY_CONV_W, I_HY_CONV_B, I_HY_W1, I_HY_B1, I_HY_W2, I_HY_B2, I_HY_W3, I_HY_B3, I_HY_W4,
       I_HY_FREQ, I_HY_LOG_DECAY, I_HY_BIAS_D, I_RW_MU_PREV, I_RW_MU_NEXT, I_RW_W0, I_RW_W2, I_RW_A0, I_RW_A2, I_RW_V0, I_RW_V1, I_RW_V2, I_RW_G2, I_RW_K_K, I_RW_K_A,
       I_RW_R_K, I_RW_LN_G, I_RW_LN_B, I_W_BR_A, I_W_BR_B, I_W_BR_C, I_W_OUT, I_NORM_FFN_G, I_W_FFN_GATE, I_W_FFN_UP, I_W_FFN_DOWN, I_NORM_FINAL_G, N_INPUTS };

constexpr size_t MiB = 1u << 20;
constexpr size_t WS_CTL = 0, CTL_ZERO_BYTES = 1 * MiB;
constexpr size_t WS_WIN = 2 * MiB;
constexpr size_t WIN_L = (size_t)NINP * D * 2;
constexpr size_t WS_WBR = WS_WIN + 4 * WIN_L;
constexpr size_t WBR_L = (size_t)3 * D * 1024 * 2;
constexpr size_t WS_WOUT = WS_WBR + 4 * WBR_L;
constexpr size_t WOUT_L = (size_t)D * D * 2;
constexpr size_t WS_WGU = WS_WOUT + 4 * WOUT_L;
constexpr size_t WGU_L = (size_t)2 * DFF * D * 2;
constexpr size_t WS_WDN = WS_WGU + 4 * WGU_L;
constexpr size_t WDN_L = (size_t)D * DFF * 2;
constexpr size_t WS_HF = WS_WDN + 4 * WDN_L;
constexpr size_t HF_L = (size_t)2 * 1024 * 4096 * 4;
constexpr size_t WS_Z3 = WS_HF + 4 * HF_L;
constexpr size_t WS_X = WS_Z3 + 2 * MiB;
constexpr size_t WS_H = WS_X + (size_t)M * D * 4;
constexpr size_t WS_PA = WS_H + (size_t)M * D * 2;
constexpr size_t WS_PC = WS_PA + (size_t)M * 2048 * 2;
constexpr size_t WS_PG = WS_PC + (size_t)M * CINP * 2;
constexpr size_t WS_PB = WS_PG + (size_t)M * 6144 * 2;
constexpr size_t WS_STATS = WS_PB + (size_t)3072 * M * 2;
constexpr size_t WS_R = WS_STATS + 1 * MiB;
constexpr size_t ACT1K = (size_t)M * 1024 * 4;
constexpr size_t WS_V = WS_R + ACT1K;
constexpr size_t WS_AA = WS_V + ACT1K;
constexpr size_t WS_WD = WS_AA + ACT1K;
constexpr size_t WS_KD = WS_WD + 2 * ACT1K;
constexpr size_t WS_BD = WS_KD + 2 * ACT1K;
constexpr size_t WS_GG = WS_BD + 2 * ACT1K;
constexpr size_t WS_VFIRST = WS_GG + ACT1K;
constexpr size_t WS_YS = WS_VFIRST + ACT1K;
constexpr size_t WS_YA = WS_YS + 2 * ACT1K;
constexpr size_t WS_YB = WS_YA + (size_t)M * 1024 * 2;
constexpr size_t WS_YC = WS_YB + (size_t)M * 1024 * 2;
constexpr size_t WS_PBR = WS_YC + (size_t)M * 1024 * 2;
constexpr size_t WS_MERGED = WS_PBR + (size_t)3 * M * D * 2;
constexpr size_t WS_ACT = WS_MERGED + (size_t)M * D * 2;
constexpr size_t WS_END = WS_ACT + (size_t)M * DFF * 2;

constexpr int CW_BAR = 4096;

constexpr int LDS_BYTES = 147456;
constexpr int LDS_MISC_OFF = 145408;
constexpr int NTHREADS = 512, NWAVES = 8;

__device__ __forceinline__ unsigned f2bf(float f) { unsigned u = __builtin_bit_cast(unsigned, f); return (u + 0x7fffu + ((u >> 16) & 1u)) >> 16; }
__device__ __forceinline__ unsigned pk2(float lo, float hi) { return f2bf(lo) | (f2bf(hi) << 16); }
__device__ __forceinline__ float bf2f(unsigned h) { return __builtin_bit_cast(float, h << 16); }
__device__ __forceinline__ float bflo(unsigned w) { return __builtin_bit_cast(float, w << 16); }
__device__ __forceinline__ float bfhi(unsigned w) { return __builtin_bit_cast(float, w & 0xffff0000u); }
__device__ __forceinline__ float wave_sum(float v) {
#pragma unroll
    for (int o = 1; o < 64; o <<= 1) v += __shfl_xor(v, o);
    return v;
}
__device__ __forceinline__ int opaque_tid() { int t = threadIdx.x; asm volatile("" : "+v"(t)); return t; }
__device__ __forceinline__ float sigmoidf_(float x) { return 1.f / (1.f + __expf(-x)); }
__device__ __forceinline__ float gelu_exact(float x) { return 0.5f * x * (1.f + erff(x * 0.70710678118654752f)); }

#define XB_TMO      128
#define XB_XCNT(j)  (256  + 64 * (j))
#define XB_XSUB(j)  (1280 + 64 * (j))
#define XB_XGEN(j)  (2304 + 64 * (j))
#define XB_TOP      3328
#define XB_TOPGEN   3392
#define XCD_BAR_WORDS 3456
#define XB_SPIN_CAP (1u << 18)

__device__ __forceinline__ unsigned xb_ld(unsigned* p)              { return __hip_atomic_load(p, __ATOMIC_RELAXED, __HIP_MEMORY_SCOPE_AGENT); }
__device__ __forceinline__ unsigned xb_add(unsigned* p, unsigned v) { return __hip_atomic_fetch_add(p, v, __ATOMIC_RELAXED, __HIP_MEMORY_SCOPE_AGENT); }
__device__ __forceinline__ unsigned xb_xcc_id() { return (unsigned)__builtin_amdgcn_s_getreg((3 << 11) | 20) & 0xFu; }
#define XB_SPIN(cond, bar) do { unsigned _sp = 0; while (cond) { __builtin_amdgcn_s_sleep(1); \
    if ((++_sp & 255u) == 0u) { if (xb_ld(&(bar)[XB_TMO])) break; if (_sp > XB_SPIN_CAP) { atomicAdd(&(bar)[XB_TMO], 1u); break; } } } } while (0)

struct XcdBarrier { unsigned* bar; unsigned x; volatile LAS unsigned* st; };

__device__ __forceinline__ XcdBarrier xcd_barrier_post(unsigned* bar, volatile LAS unsigned* st) {
    XcdBarrier b; b.bar = bar; b.x = xb_xcc_id(); b.st = st;
    if (threadIdx.x == 0) (void)xb_add(&bar[XB_XCNT(b.x)], 1u);
    return b;
}
__device__ __forceinline__ void xcd_barrier_complete(unsigned* bar, unsigned x, unsigned& nloc, unsigned& nx) {
    const unsigned G = gridDim.x * gridDim.y * gridDim.z;
    unsigned sum, cnt, mine, sp = 0u;
    for (;;) {
        sum = 0u; cnt = 0u; mine = 0u;
#pragma unroll
        for (unsigned j = 0; j < 16; ++j) { const unsigned c = xb_ld(&bar[XB_XCNT(j)]); sum += c; cnt += (c > 0u) ? 1u : 0u; mine = (j == x) ? c : mine; }
        if (sum == G) break;
        __builtin_amdgcn_s_sleep(1);
        if ((++sp & 255u) == 0u) { if (xb_ld(&bar[XB_TMO])) break; if (sp > XB_SPIN_CAP) { atomicAdd(&bar[XB_TMO], 1u); break; } }
    }
    nloc = mine > 0u ? mine : 1u; nx = cnt > 0u ? cnt : 1u;
}
__device__ __forceinline__ void xcd_barrier(const XcdBarrier& b) {
    asm volatile("s_waitcnt vmcnt(0)" ::: "memory");
    __syncthreads();
    if (threadIdx.x == 0) {
        unsigned* bar = b.bar;
        __builtin_amdgcn_s_waitcnt(0);
        unsigned nloc = b.st[0], nx = b.st[1];
        if (nloc == 0u) { xcd_barrier_complete(bar, b.x, nloc, nx); b.st[0] = nloc; b.st[1] = nx; }
        const unsigned old = xb_add(&bar[XB_XSUB(b.x)], 1u);
        const unsigned gen = old / nloc;
        if (old + 1u == (gen + 1u) * nloc) {
            __builtin_amdgcn_fence(__ATOMIC_RELEASE, "agent");
            asm volatile("s_waitcnt vmcnt(0)" ::: "memory");
            const unsigned og = xb_add(&bar[XB_TOP], 1u);
            const unsigned tg = og / nx;
            if (og + 1u == (tg + 1u) * nx) xb_add(&bar[XB_TOPGEN], 1u);
            else XB_SPIN(xb_ld(&bar[XB_TOPGEN]) == tg, bar);
            __builtin_amdgcn_fence(__ATOMIC_ACQUIRE, "agent");
            xb_add(&bar[XB_XGEN(b.x)], 1u);
            asm volatile("s_waitcnt vmcnt(0)" ::: "memory");
        } else {
            XB_SPIN(xb_ld(&bar[XB_XGEN(b.x)]) == gen, bar);
            __builtin_amdgcn_fence(__ATOMIC_ACQUIRE, "agent");
            asm volatile("s_waitcnt vmcnt(0)" ::: "memory");
        }
    }
    __syncthreads();
}

namespace pg8 {
constexpr int BM = 256, BK = 64, HALF = 128, HTB = HALF * BK * 2, STAGE_BYTES = 8 * HTB, NXCD = 8, WGM = 8;
__host__ __device__ __forceinline__ int lds_byte(int r, int c) { const int st = (r >> 4) * 2 + (c >> 5), rr = r & 15, cc = c & 31, ob = rr * 64 + cc * 2; return st * 1024 + (ob ^ (((ob >> 9) & 1) << 5)); }
__host__ __device__ __forceinline__ void stage_rc(int b, int& R, int& C) { const int st = b / 1024, sb = b % 1024, swz = sb ^ (((sb >> 9) & 1) << 5); R = (st >> 1) * 16 + swz / 64; C = (st & 1) * 32 + (swz % 64) / 2; }
__host__ __device__ __forceinline__ int perm32(int rho) { const int n = rho >> 4, i = rho & 15; return 8 * (i >> 2) + 4 * n + (i & 3); }

struct Unit { int pm, pn, seg; };
struct SegOrder {
    const bf16_t* A0; const bf16_t* B0; int nM0, nN0;
    const bf16_t* A1; const bf16_t* B1; int nM1, nN1;
    int G, c;
    __device__ __forceinline__ static void map(int L, int nM, int nN, int& pm, int& pn) {
        const int nwg = nM * nN; int wgid = L;
        { const int q = nwg / NXCD, r = nwg % NXCD, xcd = wgid % NXCD, off = wgid / NXCD; wgid = (xcd < r ? xcd * (q + 1) : r * (q + 1) + (xcd - r) * q) + off; }
        const int nig = WGM * nN, gid = wgid / nig, fm = gid * WGM, gsz = (nM - fm) < WGM ? (nM - fm) : WGM;
        pm = fm + ((wgid % nig) % gsz); pn = (wgid % nig) / gsz;
    }
    __device__ __forceinline__ bool next(int i, Unit& u) const {
        long L = (long)i * G + c; const int n0 = nM0 * nN0, n1 = nM1 * nN1;
        if (L < n0) { u.seg = 0; map((int)L, nM0, nN0, u.pm, u.pn); return true; }
        L -= n0;
        if (L < n1) { u.seg = 1; map((int)L, nM1, nN1, u.pm, u.pn); return true; }
        return false;
    }
    __device__ __forceinline__ const char* abase(const Unit& u) const { return (const char*)(u.seg ? A1 : A0); }
    __device__ __forceinline__ const char* bbase(const Unit& u) const { return (const char*)(u.seg ? B1 : B0); }
};

__device__ __forceinline__ unsigned cvt_pk_bf16(float lo, float hi) { unsigned r; asm volatile("v_cvt_pk_bf16_f32 %0, %1, %2" : "=v"(r) : "v"(lo), "v"(hi)); return r; }
__device__ __forceinline__ f32x2 gelu_pk(f32x2 v) {
    const f32x2 av = __builtin_elementwise_abs(v), d = av * 0.2316418882f + 1.0f;
    f32x2 t; t.x = __builtin_amdgcn_rcpf(d.x); t.y = __builtin_amdgcn_rcpf(d.y);
    f32x2 q = t * 0.5307027145f + (-0.7265760135f); q = q * t + 0.7107068705f; q = q * t + (-0.142248368f); q = q * t + 0.127414796f; q = q * t;
    const f32x2 s = (v * v) * (-0.72134752044f);
    f32x2 e; e.x = __builtin_amdgcn_exp2f(s.x); e.y = __builtin_amdgcn_exp2f(s.y);
    const f32x2 m = v * (q * e), r = v - m;
    f32x2 o; o.x = v.x < 0.f ? m.x : r.x; o.y = v.y < 0.f ? m.y : r.y; return o;
}
__device__ __forceinline__ float fast_sigmoid(float x) { return __builtin_amdgcn_rcpf(1.f + __builtin_amdgcn_exp2f(-1.4426950408889634f * x)); }

struct EpiInProj {
    bf16_t *PA, *PC, *PG, *PB;
    __device__ __forceinline__ void operator()(const f32x4 (&acc)[2][2][4][2], const Unit& u, int wr, int wc, int fr, int fq) const {
        const int row0 = u.pm * BM + wr * 64 + fr;
        int mode, ldc, colt; bf16_t* base;
        if (u.seg == 1) { mode = 0; ldc = M; colt = u.pn * BM; base = PB; }
        else if (u.pn < 8) { mode = 1; ldc = 2048; colt = u.pn * BM; base = PA; }
        else if (u.pn < 22) { mode = 0; ldc = CINP; colt = (u.pn - 8) * BM; base = PC; }
        else { mode = 2; ldc = 6144; colt = (u.pn - 22) * BM; base = PG; }
        const int col0 = colt + wc * 32 + 8 * fq;
#pragma unroll
        for (int ai = 0; ai < 2; ++ai)
#pragma unroll
            for (int m = 0; m < 4; ++m) { bf16_t* rowp = base + (size_t)(row0 + ai * HALF + m * 16) * ldc + col0;
#pragma unroll
                for (int bj = 0; bj < 2; ++bj) { f32x4 v0 = acc[ai][bj][m][0], v1 = acc[ai][bj][m][1];
                    if (mode == 1) { f32x2 a = gelu_pk((f32x2){v0[0], v0[1]}), b = gelu_pk((f32x2){v0[2], v0[3]}), c = gelu_pk((f32x2){v1[0], v1[1]}), d = gelu_pk((f32x2){v1[2], v1[3]});
                        v0 = (f32x4){a.x, a.y, b.x, b.y}; v1 = (f32x4){c.x, c.y, d.x, d.y}; }
                    else if (mode == 2) {
#pragma unroll
                        for (int j = 0; j < 4; ++j) { v0[j] = fast_sigmoid(v0[j]); v1[j] = fast_sigmoid(v1[j]); } }
                    u32x4 w; w.x = cvt_pk_bf16(v0[0], v0[1]); w.y = cvt_pk_bf16(v0[2], v0[3]); w.z = cvt_pk_bf16(v1[0], v1[1]); w.w = cvt_pk_bf16(v1[2], v1[3]);
                    *(u32x4*)(rowp + bj * HALF) = w; } }
    }
};
struct EpiBf16 {
    bf16_t* O; int ldc; size_t pn_stride; int pn_per;
    __device__ __forceinline__ void operator()(const f32x4 (&acc)[2][2][4][2], const Unit& u, int wr, int wc, int fr, int fq) const {
        const int row0 = u.pm * BM + wr * 64 + fr; const int tsel = u.pn / pn_per; const int col0 = (u.pn - tsel * pn_per) * BM + wc * 32 + 8 * fq;
        bf16_t* base = O + (size_t)tsel * pn_stride;
#pragma unroll
        for (int ai = 0; ai < 2; ++ai)
#pragma unroll
            for (int m = 0; m < 4; ++m) { bf16_t* rowp = base + (size_t)(row0 + ai * HALF + m * 16) * ldc + col0;
#pragma unroll
                for (int bj = 0; bj < 2; ++bj) { const f32x4 v0 = acc[ai][bj][m][0], v1 = acc[ai][bj][m][1];
                    u32x4 w; w.x = cvt_pk_bf16(v0[0], v0[1]); w.y = cvt_pk_bf16(v0[2], v0[3]); w.z = cvt_pk_bf16(v1[0], v1[1]); w.w = cvt_pk_bf16(v1[2], v1[3]);
                    *(u32x4*)(rowp + bj * HALF) = w; } }
    }
};
struct EpiSwiGlu {
    bf16_t* O; int ldc;
    __device__ __forceinline__ void operator()(const f32x4 (&acc)[2][2][4][2], const Unit& u, int wr, int wc, int fr, int fq) const {
        const int row0 = u.pm * BM + wr * 64 + fr; const int col0 = u.pn * HALF + wc * 32 + 8 * fq;
#pragma unroll
        for (int ai = 0; ai < 2; ++ai)
#pragma unroll
            for (int m = 0; m < 4; ++m) { bf16_t* rowp = O + (size_t)(row0 + ai * HALF + m * 16) * ldc + col0;
                f32x4 o0, o1;
#pragma unroll
                for (int j = 0; j < 4; ++j) { const float g0 = acc[ai][0][m][0][j], g1 = acc[ai][0][m][1][j];
                    o0[j] = g0 * fast_sigmoid(g0) * acc[ai][1][m][0][j]; o1[j] = g1 * fast_sigmoid(g1) * acc[ai][1][m][1][j]; }
                u32x4 w; w.x = cvt_pk_bf16(o0[0], o0[1]); w.y = cvt_pk_bf16(o0[2], o0[3]); w.z = cvt_pk_bf16(o1[0], o1[1]); w.w = cvt_pk_bf16(o1[2], o1[3]);
                *(u32x4*)rowp = w; }
    }
};
struct EpiResidual {
    float* X; int ldc;
    __device__ __forceinline__ void operator()(const f32x4 (&acc)[2][2][4][2], const Unit& u, int wr, int wc, int fr, int fq) const {
        const int row0 = u.pm * BM + wr * 64 + fr; const int col0 = u.pn * BM + wc * 32 + 8 * fq;
#pragma unroll
        for (int ai = 0; ai < 2; ++ai)
#pragma unroll
            for (int m = 0; m < 4; ++m) { float* rowp = X + (size_t)(row0 + ai * HALF + m * 16) * ldc + col0;
#pragma unroll
                for (int bj = 0; bj < 2; ++bj) { f32x4* p = (f32x4*)(rowp + bj * HALF); const f32x4 x0 = p[0], x1 = p[1];
                    p[0] = x0 + acc[ai][bj][m][0]; p[1] = x1 + acc[ai][bj][m][1]; } }
    }
};

template <class Epi>
__device__ __forceinline__ void gemm_phase(LAS unsigned char* lds, const int K, const SegOrder& S, const Epi& E) {
    int tid_ = threadIdx.x; asm volatile("" : "+v"(tid_));
    const int tid = tid_, wid = __builtin_amdgcn_readfirstlane(tid >> 6), lane = tid & 63, wr = wid >> 2, wc = wid & 3, fr = lane & 15, fq = lane >> 4;
    const int nt = K / BK;
    unsigned voffA[2], voffB[2];
#pragma unroll
    for (int i = 0; i < 2; ++i) { int R, C; stage_rc(tid * 16 + i * 8192, R, C); const int Rb = (R & ~31) + perm32(R & 31);
        voffA[i] = (unsigned)(R * K + C) * 2u; voffB[i] = (unsigned)(Rb * K + C) * 2u; }
    const size_t kstep = (size_t)(BK * 2);
    const size_t hstep = (size_t)HALF * K * 2;
    const size_t tstep = 2 * hstep;
    const unsigned ldsw = (unsigned)wid * 1024u;
    const int aoff = lds_byte(wr * 64 + fr, fq * 8), boff = lds_byte(wc * 32 + fr, fq * 8);
#define PG8_SA(b, h) (((b) * 2 + (h)) * HTB)
#define PG8_SB(b, h) ((4 + (b) * 2 + (h)) * HTB)
#define PG8_STAGE(bufoff, gbase, voff) do { _Pragma("unroll") for (int _i = 0; _i < 2; ++_i) \
        __builtin_amdgcn_global_load_lds((const unsigned*)((const char*)(gbase) + (voff)[_i]), (LAS unsigned*)(lds + (bufoff) + ldsw + _i * 8192), 16, 0, 0); } while (0)
#define PG8_LDA(dst, b, h) do { _Pragma("unroll") for (int m = 0; m < 4; ++m) _Pragma("unroll") for (int k = 0; k < 2; ++k) dst[m][k] = *(const LAS bf16x8*)(lds + PG8_SA(b, h) + aoff + m * 2048 + k * 1024); } while (0)
#define PG8_LDB(dst, b, h) do { _Pragma("unroll") for (int n = 0; n < 2; ++n) _Pragma("unroll") for (int k = 0; k < 2; ++k) dst[n][k] = *(const LAS bf16x8*)(lds + PG8_SB(b, h) + boff + n * 2048 + k * 1024); } while (0)
#define PG8_MMA(ai, bj, At, Bt) do { __builtin_amdgcn_s_setprio(1); _Pragma("unroll") for (int m = 0; m < 4; ++m) _Pragma("unroll") for (int n = 0; n < 2; ++n) _Pragma("unroll") for (int k = 0; k < 2; ++k) \
        acc[ai][bj][m][n] = __builtin_amdgcn_mfma_f32_16x16x32_bf16(Bt[n][k], At[m][k], acc[ai][bj][m][n], 0, 0, 0); __builtin_amdgcn_s_setprio(0); } while (0)
#define PG8_WAIT_V(n) asm volatile("s_waitcnt vmcnt(" #n ")" ::: "memory")
#define PG8_WAIT_L(n) asm volatile("s_waitcnt lgkmcnt(" #n ")" ::: "memory")
#define PG8_BAR __builtin_amdgcn_s_barrier()
#define PG8_SCHED __builtin_amdgcn_sched_barrier(0)
    Unit cur, nxt; int ui = 0;
    if (!S.next(0, cur)) return;
    f32x4 acc[2][2][4][2];
#pragma unroll
    for (int a = 0; a < 2; ++a)
#pragma unroll
        for (int b = 0; b < 2; ++b)
#pragma unroll
            for (int m = 0; m < 4; ++m)
#pragma unroll
                for (int n = 0; n < 2; ++n) acc[a][b][m][n] = (f32x4){0.f, 0.f, 0.f, 0.f};
    bf16x8 At[4][2], B0[2][2], B1[2][2];
    const char* cA = S.abase(cur) + (size_t)cur.pm * tstep; const char* cB = S.bbase(cur) + (size_t)cur.pn * tstep;
    PG8_STAGE(PG8_SB(0, 0), cB, voffB); PG8_STAGE(PG8_SB(0, 1), cB + hstep, voffB); PG8_STAGE(PG8_SA(0, 0), cA, voffA); PG8_STAGE(PG8_SA(0, 1), cA + hstep, voffA);
    if (wr == 1) PG8_BAR;
    PG8_WAIT_V(2); PG8_BAR;
    PG8_STAGE(PG8_SB(1, 0), cB + kstep, voffB); PG8_STAGE(PG8_SA(1, 0), cA + kstep, voffA); PG8_STAGE(PG8_SB(1, 1), cB + hstep + kstep, voffB);
    PG8_WAIT_V(6); PG8_BAR;
    for (;;) {
        const bool has_next = S.next(ui + 1, nxt);
        const char* nA = has_next ? S.abase(nxt) + (size_t)nxt.pm * tstep : cA; const char* nB = has_next ? S.bbase(nxt) + (size_t)nxt.pn * tstep : cB;
        for (int t = 0; t < nt; t += 2) {
            const bool last = (t == nt - 2);
            const char* a1 = cA + (size_t)(t + 1) * kstep;
            const char* a2 = last ? nA : cA + (size_t)(t + 2) * kstep; const char* b2 = last ? nB : cB + (size_t)(t + 2) * kstep;
            const char* a3 = a2 + kstep; const char* b3 = b2 + kstep;
            PG8_LDB(B0, 0, 0); PG8_LDB(B1, 0, 1); PG8_SCHED; PG8_LDA(At, 0, 0); PG8_STAGE(PG8_SA(1, 1), a1 + hstep, voffA);
            PG8_WAIT_V(8); PG8_WAIT_L(0); PG8_BAR; PG8_MMA(0, 0, At, B0); PG8_MMA(0, 1, At, B1); PG8_BAR; PG8_SCHED;
            PG8_LDA(At, 0, 1); PG8_STAGE(PG8_SB(0, 0), b2, voffB); PG8_STAGE(PG8_SB(0, 1), b2 + hstep, voffB); PG8_STAGE(PG8_SA(0, 0), a2, voffA);
            PG8_WAIT_V(8); PG8_WAIT_L(0); PG8_BAR; PG8_MMA(1, 0, At, B0); PG8_MMA(1, 1, At, B1); PG8_BAR; PG8_SCHED;
            PG8_LDB(B0, 1, 0); PG8_LDB(B1, 1, 1); PG8_SCHED; PG8_LDA(At, 1, 0); PG8_STAGE(PG8_SA(0, 1), a2 + hstep, voffA);
            PG8_WAIT_V(8); PG8_WAIT_L(0); PG8_BAR; PG8_MMA(0, 0, At, B0); PG8_MMA(0, 1, At, B1); PG8_BAR; PG8_SCHED;
            PG8_LDA(At, 1, 1); PG8_STAGE(PG8_SB(1, 0), b3, voffB); PG8_STAGE(PG8_SB(1, 1), b3 + hstep, voffB); PG8_STAGE(PG8_SA(1, 0), a3, voffA);
            PG8_WAIT_V(8); PG8_WAIT_L(0); PG8_BAR; PG8_MMA(1, 0, At, B0); PG8_MMA(1, 1, At, B1); PG8_BAR; PG8_SCHED;
        }
        if (wr == 0) PG8_BAR;
        E(acc, cur, wr, wc, fr, fq);
        if (!has_next) break;
#pragma unroll
        for (int a = 0; a < 2; ++a)
#pragma unroll
            for (int b = 0; b < 2; ++b)
#pragma unroll
                for (int m = 0; m < 4; ++m)
#pragma unroll
                    for (int n = 0; n < 2; ++n) acc[a][b][m][n] = (f32x4){0.f, 0.f, 0.f, 0.f};
        cur = nxt; cA = nA; cB = nB; ++ui;
        if (wr == 1) PG8_BAR;
    }
    PG8_WAIT_V(0);
    PG8_BAR;
#undef PG8_SA
#undef PG8_SB
#undef PG8_STAGE
#undef PG8_LDA
#undef PG8_LDB
#undef PG8_MMA
#undef PG8_WAIT_V
#undef PG8_WAIT_L
#undef PG8_BAR
#undef PG8_SCHED
}
}

struct Args { const float* in[N_INPUTS]; float* out; unsigned char* ws; int ph_lo, ph_hi; };
constexpr int PTAB_OFF = LDS_MISC_OFF + 256;
struct PT {
    LAS unsigned char* lds;
    __device__ __forceinline__ unsigned long long raw(int i) const { const u32x2 v = *(const LAS u32x2*)(lds + PTAB_OFF + 8 * i);
        return ((unsigned long long)(unsigned)__builtin_amdgcn_readfirstlane((int)v.y) << 32) | (unsigned long long)(unsigned)__builtin_amdgcn_readfirstlane((int)v.x); }
    __device__ __forceinline__ const float* in(int i) const { return (const float*)raw(i); }
    __device__ __forceinline__ float* out() const { return (float*)raw(N_INPUTS); }
    __device__ __forceinline__ unsigned char* ws() const { return (unsigned char*)raw(N_INPUTS + 1); }
};

__device__ __forceinline__ void transpose_item(const float* W, int Nsrc, int k0, int n0, bf16_t* WT, int Kd, int drow0, LAS float* scr, int lane) {
#pragma unroll 8
    for (int i = 0; i < 32; ++i) { const int kk = 2 * i + (lane >> 5); scr[kk * 33 + (lane & 31)] = W[(size_t)(k0 + kk) * Nsrc + n0 + (lane & 31)]; }
    asm volatile("s_waitcnt lgkmcnt(0)" ::: "memory");
    const int c = lane & 7;
#pragma unroll
    for (int j = 0; j < 4; ++j) { const int n = (lane >> 3) + 8 * j; const LAS float* s = scr + (8 * c) * 33 + n;
        u32x4 o; o.x = pk2(s[0 * 33], s[1 * 33]); o.y = pk2(s[2 * 33], s[3 * 33]); o.z = pk2(s[4 * 33], s[5 * 33]); o.w = pk2(s[6 * 33], s[7 * 33]);
        *(u32x4*)(WT + (size_t)(drow0 + n) * Kd + k0 + 8 * c) = o; }
    asm volatile("s_waitcnt lgkmcnt(0)" ::: "memory");
}

constexpr int IT_WIN = 32 * 458, IT_BR = 16 * 64, IT_OUT = 32 * 64, IT_GU = 32 * 176, IT_DN = 88 * 64;
constexpr int IT_LAYER = IT_WIN + 3 * IT_BR + IT_OUT + 2 * IT_GU + IT_DN;

__device__ __forceinline__ void prologue_a(const PT& a, LAS unsigned char* lds) {
    unsigned char* ws = a.ws();
    const int tid = opaque_tid(), lane = tid & 63, wave = tid >> 6;
    const int gw = blockIdx.x * NWAVES + wave, NGW = gridDim.x * NWAVES;
    const size_t gt = (size_t)blockIdx.x * NTHREADS + tid, NGT = (size_t)gridDim.x * NTHREADS;
    { const f32x4* src = (const f32x4*)a.in(I_X); f32x4* dst = (f32x4*)(ws + WS_X);
      for (size_t i = gt; i < (size_t)M * D / 4; i += NGT) dst[i] = src[i]; }
    { for (int l = 0; l < DEPTH; ++l) { u32x4* p = (u32x4*)(ws + WS_WIN + l * WIN_L + (size_t)5440 * D * 2); const size_t n = (size_t)192 * D * 2 / 16;
        for (size_t i = gt; i < n; i += NGT) p[i] = (u32x4){0u, 0u, 0u, 0u}; } }
    LAS float* scr = (LAS float*)(lds + wave * 16384);
    for (int it = gw; it < DEPTH * IT_LAYER; it += NGW) {
        const int l = it / IT_LAYER; int r = it - l * IT_LAYER;
        if (r < IT_WIN) { const int kb = r / 458, nb = r % 458, n0 = nb * 32;
            int drow; if (n0 < 2048) drow = n0; else if (n0 < 5120) drow = NIN_MAIN + (n0 - 2048); else if (n0 < 8512) drow = 2048 + (n0 - 5120); else drow = 5632 + (n0 - 8512);
            transpose_item(a.in(I_W_IN) + (size_t)l * D * NIN, NIN, kb * 64, n0, (bf16_t*)(ws + WS_WIN + l * WIN_L), D, drow, scr, lane); continue; }
        r -= IT_WIN;
        if (r < 3 * IT_BR) { const int br = r / IT_BR; r -= br * IT_BR; const int kb = r / 64, nb = r % 64;
            const float* src = a.in(br == 0 ? I_W_BR_A : (br == 1 ? I_W_BR_B : I_W_BR_C)) + (size_t)l * 1024 * D;
            transpose_item(src, D, kb * 64, nb * 32, (bf16_t*)(ws + WS_WBR + l * WBR_L) + (size_t)br * D * 1024, 1024, nb * 32, scr, lane); continue; }
        r -= 3 * IT_BR;
        if (r < IT_OUT) { const int kb = r / 64, nb = r % 64;
            transpose_item(a.in(I_W_OUT) + (size_t)l * D * D, D, kb * 64, nb * 32, (bf16_t*)(ws + WS_WOUT + l * WOUT_L), D, nb * 32, scr, lane); continue; }
        r -= IT_OUT;
        if (r < 2 * IT_GU) { const int up = r / IT_GU; r -= up * IT_GU; const int kb = r / 176, nb = r % 176, n0 = nb * 32;
            const float* src = a.in(up ? I_W_FFN_UP : I_W_FFN_GATE) + (size_t)l * D * DFF;
            transpose_item(src, DFF, kb * 64, n0, (bf16_t*)(ws + WS_WGU + l * WGU_L), D, 256 * (n0 / 128) + (n0 % 128) + 128 * up, scr, lane); continue; }
        r -= 2 * IT_GU;
        { const int kb = r / 64, nb = r % 64;
            transpose_item(a.in(I_W_FFN_DOWN) + (size_t)l * DFF * D, D, kb * 64, nb * 32, (bf16_t*)(ws + WS_WDN + l * WDN_L), DFF, nb * 32, scr, lane); }
    }
    for (int row = gw; row < DEPTH * T; row += NGW) {
        const int l = row / T, t = row % T, j = lane;
        float f = 0.f;
        if (lane == 0) f = (float)t / (float)(T - 1);
        else if (lane < HYE) { const int m = (lane - 1) & 15; const float fr = 1e-4f + (float)m * ((15.0f - 1e-4f) / 15.0f);
            const float ang = (6.283185307179586f / (float)T) * (float)t * fr; f = (lane <= 16) ? cosf(ang) : -sinf(ang); }
        const float fq = a.in(I_HY_FREQ)[l * HYF + j];
        float acc = a.in(I_HY_B1)[l * HYF + j];
        { const float* w = a.in(I_HY_W1) + (size_t)l * HYE * HYF;
          for (int i = 0; i < HYE; ++i) acc += __shfl(f, i) * w[i * HYF + j]; }
        float z = sinf(fq * acc);
        acc = a.in(I_HY_B2)[l * HYF + j];
        { const float* w = a.in(I_HY_W2) + (size_t)l * HYF * HYF;
          for (int i = 0; i < HYF; ++i) acc += __shfl(z, i) * w[i * HYF + j]; }
        z = sinf(fq * acc);
        acc = a.in(I_HY_B3)[l * HYF + j];
        { const float* w = a.in(I_HY_W3) + (size_t)l * HYF * HYF;
          for (int i = 0; i < HYF; ++i) acc += __shfl(z, i) * w[i * HYF + j]; }
        z = sinf(fq * acc);
        ((float*)(ws + WS_Z3))[(size_t)row * HYF + j] = z;
    }
}

__device__ __forceinline__ void prologue_b(const PT& a, LAS unsigned char* lds) {
    unsigned char* ws = a.ws();
    const int tid = opaque_tid(), lane = tid & 63, wave = tid >> 6;
    LAS float* w4s = (LAS float*)lds;
    LAS float* dec = w4s + 1024;
    LAS float* red = dec + 16;
    LAS float* inv = red + 128;
    for (int u = blockIdx.x; u < DEPTH * 2 * 128; u += gridDim.x) {
        const int l = u >> 8, o = (u >> 7) & 1, c0 = (u & 127) * 8;
        __syncthreads();
        for (int e = tid; e < 1024; e += NTHREADS) { const int j = e >> 4, q = e & 15, dir = q >> 3, cl = q & 7;
            w4s[q * 64 + j] = a.in(I_HY_W4)[((size_t)l * HYF + j) * 4096 + dir * 2048 + o * 1024 + c0 + cl]; }
        if (tid < 16) { const int dir = tid >> 3, cl = tid & 7; dec[tid] = expf(a.in(I_HY_LOG_DECAY)[(((size_t)l * 2 + dir) * 2 + o) * 1024 + c0 + cl]); }
        __syncthreads();
        float* hf = (float*)(ws + WS_HF) + (((size_t)l * 2 + o) * 1024 + c0) * 4096;
        if (tid < 128) red[tid] = 0.f;
        __syncthreads();
#pragma unroll 1
        for (int i = 0; i < 4; ++i) {
            const int t = tid + NTHREADS * i; const float tn = (float)t / (float)(T - 1);
            f32x4 z[16]; const f32x4* zp = (const f32x4*)((const float*)(ws + WS_Z3) + ((size_t)l * T + t) * HYF);
#pragma unroll
            for (int j = 0; j < 16; ++j) z[j] = zp[j];
#pragma unroll 1
            for (int q = 0; q < 16; ++q) { const int dir = q >> 3, cl = q & 7; const LAS f32x4* wq = (const LAS f32x4*)(w4s + q * 64);
                float acc = 0.f;
#pragma unroll
                for (int j = 0; j < 16; ++j) { const f32x4 w = wq[j]; acc += z[j][0] * w[0]; acc += z[j][1] * w[1]; acc += z[j][2] * w[2]; acc += z[j][3] * w[3]; }
                const float h = acc * expf(-tn * dec[q]);
                const float s = wave_sum(fabsf(h));
                if (lane == 0) red[wave * 16 + q] += s;
                if (dir == 0) hf[(size_t)cl * 4096 + 2048 + t] = h; else if (t >= 1) hf[(size_t)cl * 4096 + 2048 - t] = h; }
        }
        __syncthreads();
        if (tid < 8) { float s = 0.f; for (int w = 0; w < 8; ++w) s += red[w * 16 + tid] + red[w * 16 + 8 + tid]; inv[tid] = 1.f / s; }
        __syncthreads();
        for (int i = 0; i < 4; ++i) {
            const int t = tid + NTHREADS * i;
#pragma unroll
            for (int cl = 0; cl < 8; ++cl) { const float s = inv[cl];
                hf[(size_t)cl * 4096 + 2048 + t] *= s; if (t >= 1) hf[(size_t)cl * 4096 + 2048 - t] *= s; }
        }
        if (tid < 8) hf[(size_t)tid * 4096] = 0.f;
    }
}

__device__ __forceinline__ void rmsnorm_phase(const float* X, const float* g, bf16_t* Hb, float* Of) {
    const int tid = opaque_tid(), lane = tid & 63, wave = tid >> 6;
    const int gw = blockIdx.x * NWAVES + wave, NGW = gridDim.x * NWAVES;
    for (int m = gw; m < M; m += NGW) {
        const f32x4* xr = (const f32x4*)(X + (size_t)m * D) + lane;
        f32x4 v[8]; float s = 0.f;
#pragma unroll
        for (int j = 0; j < 8; ++j) { v[j] = xr[64 * j]; s += (v[j][0] * v[j][0] + v[j][1] * v[j][1]) + (v[j][2] * v[j][2] + v[j][3] * v[j][3]); }
        const float rstd = 1.f / sqrtf(wave_sum(s) * (1.f / D) + RMS_EPS);
#pragma unroll
        for (int j = 0; j < 8; ++j) { const f32x4 gv = ((const f32x4*)g)[lane + 64 * j]; const f32x4 y = v[j] * rstd * gv;
            if (Of) ((f32x4*)(Of + (size_t)m * D))[lane + 64 * j] = y;
            else { u32x2 o; o.x = pk2(y[0], y[1]); o.y = pk2(y[2], y[3]); ((u32x2*)(Hb + (size_t)m * D))[lane + 64 * j] = o; } }
    }
}

__device__ __forceinline__ void gmlp_stats_phase(const bf16_t* PA, float* stats) {
    const int tid = opaque_tid(), lane = tid & 63, wave = tid >> 6;
    const int gw = blockIdx.x * NWAVES + wave, NGW = gridDim.x * NWAVES;
    for (int m = gw; m < M; m += NGW) {
        const u32x4* p = (const u32x4*)(PA + (size_t)m * 2048 + 1024) + lane * 2;
        const u32x4 a = p[0], b = p[1];
        float v[16];
#pragma unroll
        for (int j = 0; j < 4; ++j) { v[2 * j] = bflo(a[j]); v[2 * j + 1] = bfhi(a[j]); v[8 + 2 * j] = bflo(b[j]); v[8 + 2 * j + 1] = bfhi(b[j]); }
        float s = 0.f;
#pragma unroll
        for (int j = 0; j < 16; ++j) s += v[j];
        const float mu = wave_sum(s) * (1.f / 1024.f); float s2 = 0.f;
#pragma unroll
        for (int j = 0; j < 16; ++j) { const float d = v[j] - mu; s2 += d * d; }
        const float rstd = 1.f / sqrtf(wave_sum(s2) * (1.f / 1024.f) + LN_EPS);
        if (lane == 0) { stats[2 * m] = mu; stats[2 * m + 1] = rstd; }
    }
}

__device__ __forceinline__ void gmlp_unit(const PT& a, int l, int u, LAS unsigned char* lds) {
    unsigned char* ws = a.ws();
    const int tid = opaque_tid();
    const int g = u & 7, ck = u >> 3;
    const int tok0 = ck * CHUNK;
    LAS float* vn = (LAS float*)lds;
    LAS float* wsT = vn + 128 * 128;
    const bf16_t* PA = (const bf16_t*)(ws + WS_PA); const float* stats = (const float*)(ws + WS_STATS);
    const float* lng = a.in(I_GM_LN_G) + l * AW + g * 128; const float* lnb = a.in(I_GM_LN_B) + l * AW + g * 128;
    __syncthreads();
    for (int e = tid; e < 128 * 128; e += NTHREADS) { const int q = e >> 7, d = e & 127;
        const float x = bf2f(PA[(size_t)(tok0 + q) * 2048 + 1024 + g * 128 + d]);
        vn[e] = (x - stats[2 * (tok0 + q)]) * stats[2 * (tok0 + q) + 1] * lng[d] + lnb[d]; }
    { const float* wsrc = a.in(I_GM_WS) + ((size_t)l * AG + g) * 128 * 128;
      for (int e = tid; e < 128 * 128; e += NTHREADS) { const int p = e >> 7, q = e & 127; wsT[q * 128 + p] = wsrc[e]; } }
    __syncthreads();
    const int dg = tid & 31, pg = tid >> 5;
    float acc[8][4];
#pragma unroll
    for (int i = 0; i < 8; ++i)
#pragma unroll
        for (int j = 0; j < 4; ++j) acc[i][j] = 0.f;
    for (int q = 0; q < 128; ++q) {
        const f32x4 vv = *(const LAS f32x4*)(vn + q * 128 + 4 * dg);
        const f32x4 w0 = *(const LAS f32x4*)(wsT + q * 128 + 8 * pg), w1 = *(const LAS f32x4*)(wsT + q * 128 + 8 * pg + 4);
#pragma unroll
        for (int j = 0; j < 4; ++j) {
#pragma unroll
            for (int i = 0; i < 4; ++i) { acc[i][j] += w0[i] * vv[j]; acc[4 + i][j] += w1[i] * vv[j]; } }
    }
    const float* bs = a.in(I_GM_BS) + ((size_t)l * AG + g) * 128;
    bf16_t* YA = (bf16_t*)(ws + WS_YA);
#pragma unroll
    for (int i = 0; i < 8; ++i) { const int p = 8 * pg + i; const float bb = bs[p];
        const u32x2 uu = *(const u32x2*)(PA + (size_t)(tok0 + p) * 2048 + g * 128 + 4 * dg);
        const float y0 = bflo(uu.x) * (acc[i][0] + bb), y1 = bfhi(uu.x) * (acc[i][1] + bb), y2 = bflo(uu.y) * (acc[i][2] + bb), y3 = bfhi(uu.y) * (acc[i][3] + bb);
        u32x2 o; o.x = pk2(y0, y1); o.y = pk2(y2, y3);
        *(u32x2*)(YA + (size_t)(tok0 + p) * 1024 + g * 128 + 4 * dg) = o; }
}

__device__ __forceinline__ float hy_cv(const bf16_t* row, int t, float w0, float w1, float w2, float cb) {
    const float c = bf2f(row[t]); const float p = t > 0 ? bf2f(row[t - 1]) : 0.f; const float n = t < T - 1 ? bf2f(row[t + 1]) : 0.f;
    return w0 * p + w1 * c + w2 * n + cb;
}
__device__ __forceinline__ void hyena_unit(const PT& a, int l, int c, LAS unsigned char* lds) {
    unsigned char* ws = a.ws();
    const int tid = opaque_tid();
    LAS float* taps = (LAS float*)lds;
    LAS float* zin = taps + 4096;
    const bf16_t* PB = (const bf16_t*)(ws + WS_PB);
    const float* cw = a.in(I_HY_CONV_W) + (size_t)l * 3 * 3072; const float* cb = a.in(I_HY_CONV_B) + (size_t)l * 3072;
    const float* hf = (const float*)(ws + WS_HF) + (((size_t)l * 2 + 0) * 1024 + c) * 4096;
    const float bd0 = a.in(I_HY_BIAS_D)[(l * 2 + 0) * 1024 + c], bd1 = a.in(I_HY_BIAS_D)[(l * 2 + 1) * 1024 + c];
    __syncthreads();
    for (int e = tid; e < 4096; e += NTHREADS) taps[e] = hf[e];
    { const int ch = 2048 + c; const float w0 = cw[ch], w1 = cw[3072 + ch], w2 = cw[2 * 3072 + ch], b0 = cb[ch];
      for (int e = tid; e < T * 4; e += NTHREADS) { const int b = e >> 11, t = e & (T - 1); zin[t * 4 + b] = hy_cv(PB + (size_t)ch * M + b * T, t, w0, w1, w2, b0); } }
    __syncthreads();
    float acc[4][4];
#pragma unroll
    for (int order = 0; order < 2; ++order) {
#pragma unroll
        for (int i = 0; i < 4; ++i)
#pragma unroll
            for (int b = 0; b < 4; ++b) acc[i][b] = 0.f;
        for (int s = 0; s < T; ++s) {
            const f32x4 zv = *(const LAS f32x4*)(zin + s * 4);
#pragma unroll
            for (int i = 0; i < 4; ++i) { const float k = taps[tid + NTHREADS * i - s + 2048];
#pragma unroll
                for (int b = 0; b < 4; ++b) acc[i][b] += k * zv[b]; }
        }
        const float bd = order == 0 ? bd0 : bd1;
#pragma unroll
        for (int i = 0; i < 4; ++i) { const f32x4 zv = *(const LAS f32x4*)(zin + (tid + NTHREADS * i) * 4);
#pragma unroll
            for (int b = 0; b < 4; ++b) acc[i][b] += bd * zv[b]; }
        __syncthreads();
        const int ch = order == 0 ? c : 1024 + c;
        const float w0 = cw[ch], w1 = cw[3072 + ch], w2 = cw[2 * 3072 + ch], b0 = cb[ch];
        if (order == 0) {
#pragma unroll
            for (int i = 0; i < 4; ++i) { const int t = tid + NTHREADS * i; f32x4 o;
#pragma unroll
                for (int b = 0; b < 4; ++b) o[b] = acc[i][b] * hy_cv(PB + (size_t)ch * M + b * T, t, w0, w1, w2, b0);
                *(LAS f32x4*)(zin + t * 4) = o; }
            for (int e = tid; e < 4096; e += NTHREADS) taps[e] = hf[(size_t)1024 * 4096 + e];
            __syncthreads();
        } else {
            bf16_t* YB = (bf16_t*)(ws + WS_YB);
#pragma unroll
            for (int i = 0; i < 4; ++i) { const int t = tid + NTHREADS * i;
#pragma unroll
                for (int b = 0; b < 4; ++b) YB[(size_t)(b * T + t) * 1024 + c] = (bf16_t)f2bf(acc[i][b] * hy_cv(PB + (size_t)ch * M + b * T, t, w0, w1, w2, b0)); }
        }
    }
}

typedef float f32x16 __attribute__((ext_vector_type(16)));
constexpr int HYK_OFF = 0, HYZ_OFF = 65536, HYZ_PITCH = 320, HYT_OFF = HYZ_OFF + 25088;
__device__ __forceinline__ void hy_cv4(const bf16_t* row, int t0, float w0, float w1, float w2, float cb, float (&o)[4]) {
    const u32x2 x = *(const u32x2*)(row + t0);
    const float xm = t0 > 0 ? bf2f(row[t0 - 1]) : 0.f, xp = t0 + 4 < T ? bf2f(row[t0 + 4]) : 0.f;
    const float x0 = bflo(x.x), x1 = bfhi(x.x), x2 = bflo(x.y), x3 = bfhi(x.y);
    o[0] = w0 * xm + w1 * x0 + w2 * x1 + cb; o[1] = w0 * x0 + w1 * x1 + w2 * x2 + cb; o[2] = w0 * x1 + w1 * x2 + w2 * x3 + cb; o[3] = w0 * x2 + w1 * x3 + w2 * xp + cb;
}
__device__ __forceinline__ void hy_build_taps(LAS unsigned char* lds, const float* hf, int tid) {
    LAS float* tapf = (LAS float*)(lds + HYT_OFF);
    for (int e = tid; e < 1024; e += NTHREADS) *(LAS f32x4*)(tapf + 4 * e) = *(const f32x4*)(hf + 4 * e);
    __syncthreads();
#pragma unroll
    for (int i = 0; i < 8; ++i) { const int uid = tid + NTHREADS * i, yq = uid >> 3, sg = uid & 7; const int i0 = 4096 - 8 * yq + sg;
        float v[8];
#pragma unroll
        for (int e = 0; e < 8; ++e) { const int idx = i0 - e; v[e] = idx < 4096 ? tapf[idx] : 0.f; }
        u32x4 o; o.x = pk2(v[0], v[1]); o.y = pk2(v[2], v[3]); o.z = pk2(v[4], v[5]); o.w = pk2(v[6], v[7]);
        *(LAS u32x4*)(lds + HYK_OFF + uid * 16) = o; }
    __syncthreads();
}
__device__ __forceinline__ void hy_conv_mfma(LAS unsigned char* lds, int i0, int lane, f32x16& acc) {
    const int j = lane & 31, hh = lane >> 5, jq = j >> 3, jr = j & 7, bl = j >> 2, b = j & 3;
    const int dmin = i0 - 63;
    const LAS unsigned char* ap = lds + HYK_OFF + (256 - 4 * dmin - jq + hh) * 128 + jr * 16;
    const LAS unsigned char* bp = lds + HYZ_OFF + (i0 + bl - dmin + 7) * HYZ_PITCH + hh * 64 + b * 16;
#pragma unroll 2
    for (int d = 0; d < 71; ++d) {
        const bf16x8 a0 = *(const LAS bf16x8*)(ap), a1 = *(const LAS bf16x8*)(ap + 256);
        const bf16x8 b0 = *(const LAS bf16x8*)(bp), b1 = *(const LAS bf16x8*)(bp + 128);
        acc = __builtin_amdgcn_mfma_f32_32x32x16_bf16(a0, b0, acc, 0, 0, 0);
        acc = __builtin_amdgcn_mfma_f32_32x32x16_bf16(a1, b1, acc, 0, 0, 0);
        ap -= 512; bp -= HYZ_PITCH;
    }
}
__device__ __forceinline__ void hyena_unit2(const PT& a, int l, int c, LAS unsigned char* lds) {
    unsigned char* ws = a.ws();
    const int tid = opaque_tid(), lane = tid & 63, wave = __builtin_amdgcn_readfirstlane(tid >> 6);
    const bf16_t* PB = (const bf16_t*)(ws + WS_PB);
    const float* cw = a.in(I_HY_CONV_W) + (size_t)l * 3 * 3072; const float* cb = a.in(I_HY_CONV_B) + (size_t)l * 3072;
    const float* hf = (const float*)(ws + WS_HF) + (((size_t)l * 2 + 0) * 1024 + c) * 4096;
    const float bd0 = a.in(I_HY_BIAS_D)[(l * 2 + 0) * 1024 + c], bd1 = a.in(I_HY_BIAS_D)[(l * 2 + 1) * 1024 + c];
    __syncthreads();
    { const int ch = 2048 + c; const float w0 = cw[ch], w1 = cw[3072 + ch], w2 = cw[2 * 3072 + ch], b0 = cb[ch];
      for (int e = tid; e < 2 * 7 * HYZ_PITCH / 4; e += NTHREADS) { const int off = e * 4; ((LAS unsigned*)(lds + HYZ_OFF + (off < 7 * HYZ_PITCH ? off : off + 64 * HYZ_PITCH)))[0] = 0u; }
#pragma unroll
      for (int i = 0; i < 4; ++i) { const int e = tid + NTHREADS * i, b = e >> 9, t0 = (e & 511) * 4; float o[4];
          hy_cv4(PB + (size_t)ch * M + b * T, t0, w0, w1, w2, b0, o);
          u32x2 pk; pk.x = pk2(o[0], o[1]); pk.y = pk2(o[2], o[3]);
          *(LAS u32x2*)(lds + HYZ_OFF + ((t0 >> 5) + 7) * HYZ_PITCH + ((t0 >> 3) & 3) * 64 + b * 16 + (t0 & 7) * 2) = pk; } }
    hy_build_taps(lds, hf, tid);
    const int i0 = wave * 8, n = lane & 31, hh = lane >> 5, bl = n >> 2, b = n & 3, blk = i0 + bl;
    float zf[16];
    {   f32x16 acc;
#pragma unroll
        for (int r = 0; r < 16; ++r) acc[r] = 0.f;
        hy_conv_mfma(lds, i0, lane, acc);
        const float w0 = cw[c], w1 = cw[3072 + c], w2 = cw[2 * 3072 + c], b0 = cb[c];
#pragma unroll
        for (int g = 0; g < 4; ++g) { const int t0 = 32 * blk + 8 * g + 4 * hh;
            const u32x2 zo = *(const LAS u32x2*)(lds + HYZ_OFF + (blk + 7) * HYZ_PITCH + g * 64 + b * 16 + 8 * hh);
            float x1[4]; hy_cv4(PB + (size_t)c * M + b * T, t0, w0, w1, w2, b0, x1);
            zf[4 * g + 0] = x1[0] * (acc[4 * g + 0] + bd0 * bflo(zo.x)); zf[4 * g + 1] = x1[1] * (acc[4 * g + 1] + bd0 * bfhi(zo.x));
            zf[4 * g + 2] = x1[2] * (acc[4 * g + 2] + bd0 * bflo(zo.y)); zf[4 * g + 3] = x1[3] * (acc[4 * g + 3] + bd0 * bfhi(zo.y)); }
    }
    __syncthreads();
#pragma unroll
    for (int g = 0; g < 4; ++g) { u32x2 pk; pk.x = pk2(zf[4 * g], zf[4 * g + 1]); pk.y = pk2(zf[4 * g + 2], zf[4 * g + 3]);
        *(LAS u32x2*)(lds + HYZ_OFF + (blk + 7) * HYZ_PITCH + g * 64 + b * 16 + 8 * hh) = pk; }
    hy_build_taps(lds, hf + (size_t)1024 * 4096, tid);
    {   f32x16 acc;
#pragma unroll
        for (int r = 0; r < 16; ++r) acc[r] = 0.f;
        hy_conv_mfma(lds, i0, lane, acc);
        const int ch = 1024 + c; const float w0 = cw[ch], w1 = cw[3072 + ch], w2 = cw[2 * 3072 + ch], b0 = cb[ch];
        bf16_t* YB = (bf16_t*)(ws + WS_YB);
#pragma unroll
        for (int g = 0; g < 4; ++g) { const int t0 = 32 * blk + 8 * g + 4 * hh;
            float x2[4]; hy_cv4(PB + (size_t)ch * M + b * T, t0, w0, w1, w2, b0, x2);
#pragma unroll
            for (int q = 0; q < 4; ++q) YB[(size_t)(b * T + t0 + q) * 1024 + c] = (bf16_t)f2bf(x2[q] * (acc[4 * g + q] + bd1 * zf[4 * g + q])); }
    }
}

__device__ __forceinline__ float softplusf_(float x) { return fmaxf(x, 0.f) + log1pf(expf(-fabsf(x))); }
__device__ __forceinline__ float rw_mix(const bf16_t* PC, int tok, int x, float mp, float mn) {
    const int t = tok & (T - 1);
    const float c = bf2f(PC[(size_t)tok * CINP + x]);
    const float p = t > 0 ? bf2f(PC[(size_t)(tok - 1) * CINP + x]) : 0.f;
    const float n = t < T - 1 ? bf2f(PC[(size_t)(tok + 1) * CINP + x]) : 0.f;
    return c + mp * (p - c) + mn * (n - c);
}
__device__ __forceinline__ void rwkv_prep_unit(const PT& a, int l, int u, LAS unsigned char* lds) {
    unsigned char* ws = a.ws();
    const int tid = opaque_tid();
    const int tok0 = u * 8;
    const bf16_t* PC = (const bf16_t*)(ws + WS_PC);
    const float* mup = a.in(I_RW_MU_PREV) + (size_t)l * CIN; const float* mun = a.in(I_RW_MU_NEXT) + (size_t)l * CIN;
    LAS float* sg = (LAS float*)lds;
    LAS float* tw = sg + 8 * 128;
    LAS float* ad = tw + 8 * 96;
    LAS float* vv1 = ad + 8 * 96;
    LAS float* vmx = vv1 + 8 * 32;
    __syncthreads();
    for (int e = tid; e < 8 * 320; e += NTHREADS) { const int j = e / 320, xx = e - j * 320, x = 3072 + xx;
        const float c = rw_mix(PC, tok0 + j, x, mup[x], mun[x]);
        if (xx < 128) sg[j * 128 + xx] = sigmoidf_(c); else if (xx < 224) tw[j * 96 + (xx - 128)] = tanhf(c); else ad[j * 96 + (xx - 224)] = c; }
    if (l > 0) {
        for (int e = tid; e < 8 * 1024; e += NTHREADS) { const int j = e >> 10, ch = e & 1023; vmx[e] = rw_mix(PC, tok0 + j, 2048 + ch, mup[2048 + ch], mun[2048 + ch]); }
        __syncthreads();
        if (tid < 256) { const int j = tid >> 5, r = tid & 31; const float* v1 = a.in(I_RW_V1) + (size_t)(l - 1) * 1024 * VL; float acc = 0.f;
            for (int c = 0; c < 1024; ++c) acc += vmx[j * 1024 + c] * v1[c * VL + r];
            vv1[j * 32 + r] = acc; }
    }
    __syncthreads();
    float *Rb = (float*)(ws + WS_R), *Vb = (float*)(ws + WS_V), *Ab = (float*)(ws + WS_AA), *Wb = (float*)(ws + WS_WD), *Kb = (float*)(ws + WS_KD), *Bb = (float*)(ws + WS_BD),
          *Gb = (float*)(ws + WS_GG), *VF = (float*)(ws + WS_VFIRST);
#pragma unroll 1
    for (int half = 0; half < 2; ++half) {
        const int ch = tid + NTHREADS * half;
        float accw[2][8], acca[2][8], accg[8], accv[8];
#pragma unroll
        for (int j = 0; j < 8; ++j) { accw[0][j] = accw[1][j] = acca[0][j] = acca[1][j] = accg[j] = accv[j] = 0.f; }
        { const float* w2 = a.in(I_RW_W2) + (size_t)l * 2 * WL * 1024; const float* a2 = a.in(I_RW_A2) + (size_t)l * 2 * AL * 1024;
#pragma unroll
          for (int d = 0; d < 2; ++d)
            for (int r = 0; r < 48; ++r) { const float ww = w2[(size_t)(d * 48 + r) * 1024 + ch], wa = a2[(size_t)(d * 48 + r) * 1024 + ch];
#pragma unroll
                for (int j = 0; j < 8; ++j) { accw[d][j] += tw[j * 96 + d * 48 + r] * ww; acca[d][j] += ad[j * 96 + d * 48 + r] * wa; } } }
        { const float* g2 = a.in(I_RW_G2) + (size_t)l * GL * 1024;
          for (int r = 0; r < GL; ++r) { const float w = g2[(size_t)r * 1024 + ch];
#pragma unroll
              for (int j = 0; j < 8; ++j) accg[j] += sg[j * 128 + r] * w; } }
        if (l > 0) { const float* v2 = a.in(I_RW_V2) + (size_t)(l - 1) * VL * 1024;
          for (int r = 0; r < VL; ++r) { const float w = v2[(size_t)r * 1024 + ch];
#pragma unroll
              for (int j = 0; j < 8; ++j) accv[j] += vv1[j * 32 + r] * w; } }
        const float w00 = a.in(I_RW_W0)[(l * 2 + 0) * 1024 + ch], w01 = a.in(I_RW_W0)[(l * 2 + 1) * 1024 + ch];
        const float a00 = a.in(I_RW_A0)[(l * 2 + 0) * 1024 + ch], a01 = a.in(I_RW_A0)[(l * 2 + 1) * 1024 + ch];
        const float kkw = a.in(I_RW_K_K)[l * 1024 + ch], kaw = a.in(I_RW_K_A)[l * 1024 + ch];
        const float v0w = l > 0 ? a.in(I_RW_V0)[(l - 1) * 1024 + ch] : 0.f;
        const float mpr = mup[ch], mnr = mun[ch], mpk = mup[1024 + ch], mnk = mun[1024 + ch], mpv = mup[2048 + ch], mnv = mun[2048 + ch];
#pragma unroll
        for (int j = 0; j < 8; ++j) {
            const int tok = tok0 + j; const size_t o = (size_t)tok * 1024 + ch;
            const float r = rw_mix(PC, tok, ch, mpr, mnr), k = rw_mix(PC, tok, 1024 + ch, mpk, mnk);
            float v;
            if (l == 0) { v = rw_mix(PC, tok, 2048 + ch, mpv, mnv); VF[o] = v; }
            else { v = vmx[j * 1024 + ch]; v = v + (VF[o] - v) * sigmoidf_(v0w + accv[j]); }
            float kk = k * kkw; const float ss = wave_sum(kk * kk); kk = kk / fmaxf(sqrtf(ss), 1e-12f);
            Rb[o] = r; Vb[o] = v; Ab[o] = -kk; Gb[o] = accg[j];
#pragma unroll
            for (int d = 0; d < 2; ++d) {
                const float wl = -softplusf_(-((d ? w01 : w00) + accw[d][j])) - 0.5f;
                const float decay = expf(-expf(wl));
                const float aa = sigmoidf_((d ? a01 : a00) + acca[d][j]);
                const size_t od = (size_t)d * M * 1024 + o;
                Wb[od] = decay; Kb[od] = k * (1.f + (aa - 1.f) * kaw); Bb[od] = kk * aa;
            }
        }
    }
}

struct ScanIn { f32x4 a0, a1, w0, w1, b0, b1, k0, k1, r0, r1; float v; };
__device__ __forceinline__ void scan_load(ScanIn& s, const float* Ab, const float* Wb, const float* Bb, const float* Kb, const float* Rb, const float* Vb, size_t base, int cg, int row) {
    const size_t o = base + cg * 8;
    s.a0 = *(const f32x4*)(Ab + o); s.a1 = *(const f32x4*)(Ab + o + 4); s.w0 = *(const f32x4*)(Wb + o); s.w1 = *(const f32x4*)(Wb + o + 4);
    s.b0 = *(const f32x4*)(Bb + o); s.b1 = *(const f32x4*)(Bb + o + 4); s.k0 = *(const f32x4*)(Kb + o); s.k1 = *(const f32x4*)(Kb + o + 4);
    s.r0 = *(const f32x4*)(Rb + o); s.r1 = *(const f32x4*)(Rb + o + 4); s.v = Vb[base + row];
}
__device__ __forceinline__ float red8(float v) { v += __shfl_xor(v, 1); v += __shfl_xor(v, 2); v += __shfl_xor(v, 4); return v; }
__device__ __forceinline__ void wkv_scan_seq(const PT& a, int seq) {
    unsigned char* ws = a.ws();
    const int tid = opaque_tid(), lane = tid & 63, wave = tid >> 6;
    const int dir = seq >> 6, b = (seq >> 4) & 3, h = seq & 15;
    const int cg = lane & 7, row = wave * 8 + (lane >> 3);
    const float *Rb = (const float*)(ws + WS_R), *Vb = (const float*)(ws + WS_V), *Ab = (const float*)(ws + WS_AA);
    const float *Wb = (const float*)(ws + WS_WD) + (size_t)dir * M * 1024, *Kb = (const float*)(ws + WS_KD) + (size_t)dir * M * 1024, *Bb = (const float*)(ws + WS_BD) + (size_t)dir * M * 1024;
    float* Y = (float*)(ws + WS_YS) + (size_t)dir * M * 1024;
    f32x4 S0 = {0.f, 0.f, 0.f, 0.f}, S1 = {0.f, 0.f, 0.f, 0.f};
    ScanIn cur, nxt;
    { const int tt = dir ? T - 1 : 0; scan_load(cur, Ab, Wb, Bb, Kb, Rb, Vb, (size_t)(b * T + tt) * 1024 + h * 64, cg, row); }
    for (int step = 0; step < T; ++step) {
        const int tt = dir ? T - 1 - step : step;
        const int sn = step + 1 < T ? step + 1 : step; const int tn = dir ? T - 1 - sn : sn;
        scan_load(nxt, Ab, Wb, Bb, Kb, Rb, Vb, (size_t)(b * T + tn) * 1024 + h * 64, cg, row);
        float sa = S0[0] * cur.a0[0] + S0[1] * cur.a0[1] + S0[2] * cur.a0[2] + S0[3] * cur.a0[3] + S1[0] * cur.a1[0] + S1[1] * cur.a1[1] + S1[2] * cur.a1[2] + S1[3] * cur.a1[3];
        sa = red8(sa);
        S0 = S0 * cur.w0 + sa * cur.b0 + cur.v * cur.k0;
        S1 = S1 * cur.w1 + sa * cur.b1 + cur.v * cur.k1;
        float y = S0[0] * cur.r0[0] + S0[1] * cur.r0[1] + S0[2] * cur.r0[2] + S0[3] * cur.r0[3] + S1[0] * cur.r1[0] + S1[1] * cur.r1[1] + S1[2] * cur.r1[2] + S1[3] * cur.r1[3];
        y = red8(y);
        if (cg == 0) Y[(size_t)(b * T + tt) * 1024 + h * 64 + row] = y;
        cur = nxt;
    }
}

constexpr int SC_TC = 32, SC_STEP_F = 384, SC_BUF_F = SC_TC * SC_STEP_F;
template <int CTRL> __device__ __forceinline__ float dpp_mov(float v) { return __builtin_bit_cast(float, __builtin_amdgcn_update_dpp(0, __builtin_bit_cast(int, v), CTRL, 0xf, 0xf, true)); }
__device__ __forceinline__ float red8d(float v) { v += dpp_mov<0xB1>(v); v += dpp_mov<0x4E>(v); v += dpp_mov<0x141>(v); return v; }
__device__ __forceinline__ float dot8(const f32x4& s0, const f32x4& s1, const f32x4& x0, const f32x4& x1) {
    const f32x4 p = s0 * x0 + s1 * x1; return (p[0] + p[1]) + (p[2] + p[3]); }
__device__ __forceinline__ void scan_stage_chunk(LAS float* dst, int lt, int c, int dir, int b, int h, const float* pa, const float* pw, const float* pb, const float* pk, const float* pr, const float* pv) {
    f32x4 val[12];
#pragma unroll
    for (int i = 0; i < 12; ++i) { const int e = lt + 256 * i; const int step = e / 96, rem = e - 96 * step, vec = rem >> 4, q = rem & 15;
        const int gs = c * SC_TC + step; const int tt = dir ? T - 1 - gs : gs;
        const float* base = vec == 0 ? pa : (vec == 1 ? pw : (vec == 2 ? pb : (vec == 3 ? pk : (vec == 4 ? pr : pv))));
        val[i] = *(const f32x4*)(base + (size_t)(b * T + tt) * 1024 + h * 64 + q * 4); }
#pragma unroll
    for (int i = 0; i < 12; ++i) { const int e = lt + 256 * i; const int step = e / 96, rem = e - 96 * step;
        *(LAS f32x4*)(dst + step * SC_STEP_F + rem * 4) = val[i]; }
}
__device__ __forceinline__ void wkv_scan_seq2(const PT& a, int seq, LAS unsigned char* lds) {
    unsigned char* ws = a.ws();
    const int tid = opaque_tid(), lane = tid & 63, wave = __builtin_amdgcn_readfirstlane(tid >> 6);
    const int dir = seq >> 6, b = (seq >> 4) & 3, h = seq & 15;
    LAS float* buf = (LAS float*)lds;
    const float *pr = (const float*)(ws + WS_R), *pv = (const float*)(ws + WS_V), *pa = (const float*)(ws + WS_AA);
    const float *pw = (const float*)(ws + WS_WD) + (size_t)dir * M * 1024, *pk = (const float*)(ws + WS_KD) + (size_t)dir * M * 1024, *pb = (const float*)(ws + WS_BD) + (size_t)dir * M * 1024;
    float* Y = (float*)(ws + WS_YS) + (size_t)dir * M * 1024;
    const int cg = lane & 7, row0 = wave * 16 + 2 * (lane >> 3);
    f32x4 S00 = {0.f, 0.f, 0.f, 0.f}, S01 = S00, S10 = S00, S11 = S00;
    __syncthreads();
    if (wave >= 4) scan_stage_chunk(buf, tid - 256, 0, dir, b, h, pa, pw, pb, pk, pr, pv);
    __syncthreads();
#pragma unroll 1
    for (int c = 0; c < T / SC_TC; ++c) {
        if (wave >= 4) { if (c + 1 < T / SC_TC) scan_stage_chunk(buf + ((c + 1) & 1) * SC_BUF_F, tid - 256, c + 1, dir, b, h, pa, pw, pb, pk, pr, pv); }
        else {
            const LAS float* cb = buf + (c & 1) * SC_BUF_F + cg * 8;
            const LAS float* vb = buf + (c & 1) * SC_BUF_F + 320 + row0;
#pragma unroll 4
            for (int s = 0; s < SC_TC; ++s) {
                const LAS float* p = cb + s * SC_STEP_F;
                const f32x4 a0 = *(const LAS f32x4*)(p), a1 = *(const LAS f32x4*)(p + 4), w0 = *(const LAS f32x4*)(p + 64), w1 = *(const LAS f32x4*)(p + 68);
                const f32x4 b0 = *(const LAS f32x4*)(p + 128), b1 = *(const LAS f32x4*)(p + 132), k0 = *(const LAS f32x4*)(p + 192), k1 = *(const LAS f32x4*)(p + 196);
                const f32x4 r0 = *(const LAS f32x4*)(p + 256), r1 = *(const LAS f32x4*)(p + 260);
                const f32x2 vv = *(const LAS f32x2*)(vb + s * SC_STEP_F);
                const float sa0 = red8d(dot8(S00, S01, a0, a1)), sa1 = red8d(dot8(S10, S11, a0, a1));
                S00 = S00 * w0 + sa0 * b0 + vv[0] * k0; S01 = S01 * w1 + sa0 * b1 + vv[0] * k1;
                S10 = S10 * w0 + sa1 * b0 + vv[1] * k0; S11 = S11 * w1 + sa1 * b1 + vv[1] * k1;
                const float y0 = red8d(dot8(S00, S01, r0, r1)), y1 = red8d(dot8(S10, S11, r0, r1));
                const int gs = c * SC_TC + s; const int tt = dir ? T - 1 - gs : gs;
                if (cg == 0) *(f32x2*)(Y + (size_t)(b * T + tt) * 1024 + h * 64 + row0) = (f32x2){y0, y1};
            }
        }
        __syncthreads();
    }
}

__device__ __forceinline__ void rwkv_post_phase(const PT& a, int l) {
    unsigned char* ws = a.ws();
    const int tid = opaque_tid();
    const float *Rb = (const float*)(ws + WS_R), *Vb = (const float*)(ws + WS_V), *Kb = (const float*)(ws + WS_KD), *Gb = (const float*)(ws + WS_GG), *Y = (const float*)(ws + WS_YS);
    bf16_t* YC = (bf16_t*)(ws + WS_YC);
    for (int tok = blockIdx.x; tok < M; tok += gridDim.x) {
#pragma unroll
        for (int half = 0; half < 2; ++half) {
            const int ch = tid + NTHREADS * half; const size_t o = (size_t)tok * 1024 + ch;
            const float y = Y[o] + Y[(size_t)M * 1024 + o];
            const float mu = wave_sum(y) * (1.f / 64.f); const float d = y - mu; const float var = wave_sum(d * d) * (1.f / 64.f);
            const float yn = d * (1.f / sqrtf(var + GN_EPS)) * a.in(I_RW_LN_G)[l * 1024 + ch] + a.in(I_RW_LN_B)[l * 1024 + ch];
            const float r = Rb[o]; const float bon = wave_sum(r * (Kb[o] + Kb[(size_t)M * 1024 + o]) * a.in(I_RW_R_K)[l * 1024 + ch]);
            const float out = (yn + bon * Vb[o]) * Gb[o];
            YC[o] = (bf16_t)f2bf(out);
        }
    }
}

__device__ __forceinline__ void merge_phase(const PT& a) {
    unsigned char* ws = a.ws();
    const size_t gt = (size_t)blockIdx.x * NTHREADS + opaque_tid(), NGT = (size_t)gridDim.x * NTHREADS;
    const bf16_t* PG = (const bf16_t*)(ws + WS_PG); const bf16_t* PBR = (const bf16_t*)(ws + WS_PBR); bf16_t* MG = (bf16_t*)(ws + WS_MERGED);
    for (size_t i = gt; i < (size_t)M * D / 8; i += NGT) {
        const size_t m = i / (D / 8), c = (i % (D / 8)) * 8;
        float acc[8];
#pragma unroll
        for (int j = 0; j < 8; ++j) acc[j] = 0.f;
#pragma unroll
        for (int br = 0; br < 3; ++br) {
            const u32x4 g = *(const u32x4*)(PG + m * 6144 + br * 2048 + c); const u32x4 p = *(const u32x4*)(PBR + ((size_t)br * M + m) * D + c);
#pragma unroll
            for (int j = 0; j < 4; ++j) { acc[2 * j] += bflo(g[j]) * bflo(p[j]); acc[2 * j + 1] += bfhi(g[j]) * bfhi(p[j]); }
        }
        u32x4 o; o.x = pk2(acc[0], acc[1]); o.y = pk2(acc[2], acc[3]); o.z = pk2(acc[4], acc[5]); o.w = pk2(acc[6], acc[7]);
        *(u32x4*)(MG + m * D + c) = o;
    }
}

constexpr int PH_PRO_A = 0, PH_PRO_B = 1, PH_LAYER0 = 2, PH_PER_LAYER = 11, PH_FINAL = PH_LAYER0 + DEPTH * PH_PER_LAYER, N_PHASES = PH_FINAL + 1;

__global__ void __launch_bounds__(NTHREADS, 2) mk_fwd(Args args) {
    extern __shared__ __attribute__((aligned(16))) unsigned char lds_raw[];
    LAS unsigned char* lds = (LAS unsigned char*)lds_raw;
    const int tid = threadIdx.x;
    volatile LAS unsigned* misc = (volatile LAS unsigned*)(lds + LDS_MISC_OFF);
    if (tid < 64) misc[tid] = 0u;
    if (tid < 64) {   LAS unsigned long long* tab = (LAS unsigned long long*)(lds + PTAB_OFF);
        unsigned long long v = 0ull;
#pragma unroll
        for (int i = 0; i < N_INPUTS; ++i) v = (tid == i) ? (unsigned long long)args.in[i] : v;
        v = (tid == N_INPUTS) ? (unsigned long long)args.out : v;
        v = (tid == N_INPUTS + 1) ? (unsigned long long)args.ws : v;
        tab[tid] = v; }
    __syncthreads();
    const PT pt{lds};
    XcdBarrier bar = xcd_barrier_post((unsigned*)(pt.ws() + WS_CTL) + CW_BAR, misc + 8);
    const int lo = args.ph_lo, hi = args.ph_hi;
    const int G = gridDim.x, bid = blockIdx.x;
#define IN(k) (lo <= (k) && (k) < hi)
#define SEAM(k) do { if ((k) + 1 < hi) xcd_barrier(bar); } while (0)

    if (IN(PH_PRO_A)) { prologue_a(pt, lds); SEAM(PH_PRO_A); }
    if (IN(PH_PRO_B)) { prologue_b(pt, lds); SEAM(PH_PRO_B); }

#pragma unroll 1
    for (int l = 0; l < DEPTH; ++l) {
        const int p0 = PH_LAYER0 + l * PH_PER_LAYER;
        unsigned char* ws = pt.ws();
        float* X = (float*)(ws + WS_X); bf16_t* Hb = (bf16_t*)(ws + WS_H);
        if (IN(p0 + 0)) { rmsnorm_phase(X, pt.in(I_NORM_MIX_G) + l * D, Hb, nullptr); SEAM(p0 + 0); }
        if (IN(p0 + 1)) {
            const bf16_t* W = (const bf16_t*)(ws + WS_WIN + l * WIN_L);
            pg8::SegOrder S{Hb, W, M / 256, NIN_MAIN / 256, W + (size_t)NIN_MAIN * D, Hb, 3 * BW / 256, M / 256, G, bid};
            pg8::EpiInProj E{(bf16_t*)(ws + WS_PA), (bf16_t*)(ws + WS_PC), (bf16_t*)(ws + WS_PG), (bf16_t*)(ws + WS_PB)};
            pg8::gemm_phase<pg8::EpiInProj>(lds, D, S, E);
            SEAM(p0 + 1);
        }
        if (IN(p0 + 2)) {
            gmlp_stats_phase((const bf16_t*)(ws + WS_PA), (float*)(ws + WS_STATS));
            for (int u = bid; u < M / 8; u += G) rwkv_prep_unit(pt, l, u, lds);
            SEAM(p0 + 2);
        }
        if (IN(p0 + 3)) {
            if (G >= 256) {
                if (bid < 128) wkv_scan_seq2(pt, bid, lds);
                else { const int ob = bid - 128, on = G - 128;
                    for (int c = ob; c < BW; c += on) hyena_unit2(pt, l, c, lds);
                    for (int u = ob; u < 512; u += on) gmlp_unit(pt, l, u, lds); }
            } else {
                for (int s = bid; s < 128; s += G) wkv_scan_seq2(pt, s, lds);
                for (int c = bid; c < BW; c += G) hyena_unit2(pt, l, c, lds);
                for (int u = bid; u < 512; u += G) gmlp_unit(pt, l, u, lds);
            }
            SEAM(p0 + 3);
        }
        if (IN(p0 + 4)) { rwkv_post_phase(pt, l); SEAM(p0 + 4); }
        if (IN(p0 + 5)) {
            const bf16_t* W = (const bf16_t*)(ws + WS_WBR + l * WBR_L);
#pragma unroll 1
            for (int br = 0; br < 3; ++br) {
                const bf16_t* Y = (const bf16_t*)(ws + (br == 0 ? WS_YA : (br == 1 ? WS_YB : WS_YC)));
                pg8::SegOrder S{Y, W + (size_t)br * D * 1024, M / 256, D / 256, Y, W, 0, 0, G, bid};
                pg8::EpiBf16 E{(bf16_t*)(ws + WS_PBR) + (size_t)br * M * D, D, 0, 8};
                pg8::gemm_phase<pg8::EpiBf16>(lds, 1024, S, E);
            }
            SEAM(p0 + 5);
        }
        if (IN(p0 + 6)) { merge_phase(pt); SEAM(p0 + 6); }
        if (IN(p0 + 7)) {
            const bf16_t* Mg = (const bf16_t*)(ws + WS_MERGED); const bf16_t* W = (const bf16_t*)(ws + WS_WOUT + l * WOUT_L);
            pg8::SegOrder S{Mg, W, M / 256, D / 256, Mg, W, 0, 0, G, bid};
            pg8::EpiResidual E{X, D};
            pg8::gemm_phase<pg8::EpiResidual>(lds, D, S, E);
            SEAM(p0 + 7);
        }
        if (IN(p0 + 8)) { rmsnorm_phase(X, pt.in(I_NORM_FFN_G) + l * D, Hb, nullptr); SEAM(p0 + 8); }
        if (IN(p0 + 9)) {
            const bf16_t* W = (const bf16_t*)(ws + WS_WGU + l * WGU_L);
            pg8::SegOrder S{Hb, W, M / 256, 2 * DFF / 256, Hb, W, 0, 0, G, bid};
            pg8::EpiSwiGlu E{(bf16_t*)(ws + WS_ACT), DFF};
            pg8::gemm_phase<pg8::EpiSwiGlu>(lds, D, S, E);
            SEAM(p0 + 9);
        }
        if (IN(p0 + 10)) {
            const bf16_t* Ac = (const bf16_t*)(ws + WS_ACT); const bf16_t* W = (const bf16_t*)(ws + WS_WDN + l * WDN_L);
            pg8::SegOrder S{Ac, W, M / 256, D / 256, Ac, W, 0, 0, G, bid};
            pg8::EpiResidual E{X, D};
            pg8::gemm_phase<pg8::EpiResidual>(lds, DFF, S, E);
            SEAM(p0 + 10);
        }
    }
    if (IN(PH_FINAL)) rmsnorm_phase((const float*)(pt.ws() + WS_X), pt.in(I_NORM_FINAL_G), nullptr, pt.out());
#undef IN
#undef SEAM
}

extern "C" void kernel_launch(void* const* d_in, const int* in_sizes, int n_in, void* d_out, int out_size, void* d_ws, size_t ws_size, hipStream_t stream) {
    static int grid = 0;
    if (grid == 0) {
        if (n_in != N_INPUTS || out_size != M * D || ws_size < WS_END) { fprintf(stderr, "kernel_launch: unexpected shapes: n_in %d out %d ws %zu (need %zu)\n", n_in, out_size, ws_size, (size_t)WS_END); grid = -1; return; }
        int dev = 0, cus = 0, per_cu = 0;
        if (hipGetDevice(&dev) != hipSuccess || hipDeviceGetAttribute(&cus, hipDeviceAttributeMultiprocessorCount, dev) != hipSuccess) { grid = -1; return; }
        if (hipFuncSetAttribute((const void*)mk_fwd, hipFuncAttributeMaxDynamicSharedMemorySize, LDS_BYTES) != hipSuccess) { fprintf(stderr, "kernel_launch: hipFuncSetAttribute failed\n"); grid = -1; return; }
        if (hipOccupancyMaxActiveBlocksPerMultiprocessor(&per_cu, (const void*)mk_fwd, NTHREADS, LDS_BYTES) != hipSuccess || per_cu < 1) { fprintf(stderr, "kernel_launch: occupancy query says %d\n", per_cu); (void)hipGetLastError(); grid = -1; return; }
        grid = cus;
    }
    if (grid < 0) return;
    (void)hipMemsetAsync((char*)d_ws + WS_CTL, 0, CTL_ZERO_BYTES, stream);
    Args a{};
    for (int i = 0; i < N_INPUTS; ++i) a.in[i] = (const float*)d_in[i];
    a.out = (float*)d_out; a.ws = (unsigned char*)d_ws;
#if MK_LAUNCH_PER_PHASE
    for (int p = 0; p < N_PHASES; ++p) { a.ph_lo = p; a.ph_hi = p + 1; hipLaunchKernelGGL(mk_fwd, dim3(grid), dim3(NTHREADS), LDS_BYTES, stream, a); }
#else
    a.ph_lo = 0; a.ph_hi = N_PHASES;
    hipLaunchKernelGGL(mk_fwd, dim3(grid), dim3(NTHREADS), LDS_BYTES, stream, a);
#endif
}
```

```cpp
#include <hip/hip_runtime.h>
#include <cstdio>
#include <cstdint>

#ifndef PROBE_DUP
#define PROBE_DUP -1
#endif
#ifndef MK_LAUNCH_PER_PHASE
#define MK_LAUNCH_PER_PHASE 0
#endif

#define GAS __attribute__((address_space(1)))
#define LAS __attribute__((address_space(3)))
typedef unsigned short bf16_t;
typedef short bf16x8 __attribute__((ext_vector_type(8)));
typedef float f32x4 __attribute__((ext_vector_type(4)));
typedef float f32x2 __attribute__((ext_vector_type(2)));
typedef unsigned u32x4 __attribute__((ext_vector_type(4)));
typedef unsigned u32x2 __attribute__((ext_vector_type(2)));

constexpr int NB = 4, T = 2048, M = NB * T, D = 2048, DEPTH = 4;
constexpr int AW = 1024, AG = 8, CHUNK = 128;
constexpr int BW = 1024;
constexpr int CW = 1024, CH = 16, CN = 64, WL = 48, AL = 48, VL = 32, GL = 128;
constexpr int CIN = 3 * CW + GL + 2 * WL + 2 * AL;
constexpr int CINP = 3584;
constexpr int NIN = 2 * AW + 3 * BW + CIN + 3 * D;
constexpr int DFF = 5632;
constexpr int HYF = 64, HYE = 33;
constexpr float RMS_EPS = 1e-6f, LN_EPS = 1e-5f, GN_EPS = 64e-5f;
constexpr int NIN_MAIN = 2 * AW + CINP + 3 * D;
constexpr int NINP = NIN_MAIN + 3 * BW;

enum { I_X = 0, I_NORM_MIX_G, I_W_IN, I_GM_LN_G, I_GM_LN_B, I_GM_WS, I_GM_BS, I_HY_CONV_W, I_HY_CONV_B, I_HY_W1, I_HY_B1, I_HY_W2, I_HY_B2, I_HY_W3, I_HY_B3, I_HY_W4,
       I_HY_FREQ, I_HY_LOG_DECAY, I_HY_BIAS_D, I_RW_MU_PREV, I_RW_MU_NEXT, I_RW_W0, I_RW_W2, I_RW_A0, I_RW_A2, I_RW_V0, I_RW_V1, I_RW_V2, I_RW_G2, I_RW_K_K, I_RW_K_A,
       I_RW_R_K, I_RW_LN_G, I_RW_LN_B, I_W_BR_A, I_W_BR_B, I_W_BR_C, I_W_OUT, I_NORM_FFN_G, I_W_FFN_GATE, I_W_FFN_UP, I_W_FFN_DOWN, I_NORM_FINAL_G, N_INPUTS };

constexpr size_t MiB = 1u << 20;
constexpr size_t WS_CTL = 0, CTL_ZERO_BYTES = 1 * MiB;
constexpr size_t WS_WIN = 2 * MiB;
constexpr size_t WIN_L = (size_t)NINP * D * 2;
constexpr size_t WS_WBR = WS_WIN + 4 * WIN_L;
constexpr size_t WBR_L = (size_t)3 * D * 1024 * 2;
constexpr size_t WS_WOUT = WS_WBR + 4 * WBR_L;
constexpr size_t WOUT_L = (size_t)D * D * 2;
constexpr size_t WS_WGU = WS_WOUT + 4 * WOUT_L;
constexpr size_t WGU_L = (size_t)2 * DFF * D * 2;
constexpr size_t WS_WDN = WS_WGU + 4 * WGU_L;
constexpr size_t WDN_L = (size_t)D * DFF * 2;
constexpr size_t WS_HF = WS_WDN + 4 * WDN_L;
constexpr size_t HF_L = (size_t)2 * 1024 * 4096 * 4;
constexpr size_t WS_Z3 = WS_HF + 4 * HF_L;
constexpr size_t WS_X = WS_Z3 + 2 * MiB;
constexpr size_t WS_H = WS_X + (size_t)M * D * 4;
constexpr size_t WS_PA = WS_H + (size_t)M * D * 2;
constexpr size_t WS_PC = WS_PA + (size_t)M * 2048 * 2;
constexpr size_t WS_PG = WS_PC + (size_t)M * CINP * 2;
constexpr size_t WS_PB = WS_PG + (size_t)M * 6144 * 2;
constexpr size_t WS_STATS = WS_PB + (size_t)3072 * M * 2;
constexpr size_t WS_R = WS_STATS + 1 * MiB;
constexpr size_t ACT1K = (size_t)M * 1024 * 4;
constexpr size_t WS_V = WS_R + ACT1K;
constexpr size_t WS_AA = WS_V + ACT1K;
constexpr size_t WS_WD = WS_AA + ACT1K;
constexpr size_t WS_KD = WS_WD + 2 * ACT1K;
constexpr size_t WS_BD = WS_KD + 2 * ACT1K;
constexpr size_t WS_GG = WS_BD + 2 * ACT1K;
constexpr size_t WS_VFIRST = WS_GG + ACT1K;
constexpr size_t WS_YS = WS_VFIRST + ACT1K;
constexpr size_t WS_YA = WS_YS + 2 * ACT1K;
constexpr size_t WS_YB = WS_YA + (size_t)M * 1024 * 2;
constexpr size_t WS_YC = WS_YB + (size_t)M * 1024 * 2;
constexpr size_t WS_PBR = WS_YC + (size_t)M * 1024 * 2;
constexpr size_t WS_MERGED = WS_PBR + (size_t)3 * M * D * 2;
constexpr size_t WS_ACT = WS_MERGED + (size_t)M * D * 2;
constexpr size_t WS_WLORA = WS_ACT + (size_t)M * DFF * 2;
constexpr int LORA_K = 416;
constexpr size_t WLORA_L = (size_t)1024 * LORA_K * 2;
constexpr size_t WS_V1T = WS_WLORA + 4 * WLORA_L;
constexpr size_t WS_END = WS_V1T + 3 * (size_t)32 * 1024 * 2;

constexpr int CW_BAR = 4096;

constexpr int LDS_BYTES = 147456;
constexpr int LDS_MISC_OFF = 145408;
constexpr int NTHREADS = 512, NWAVES = 8;

__device__ __forceinline__ unsigned f2bf(float f) { unsigned u = __builtin_bit_cast(unsigned, f); return (u + 0x7fffu + ((u >> 16) & 1u)) >> 16; }
__device__ __forceinline__ unsigned pk2(float lo, float hi) { return f2bf(lo) | (f2bf(hi) << 16); }
__device__ __forceinline__ float bf2f(unsigned h) { return __builtin_bit_cast(float, h << 16); }
__device__ __forceinline__ float bflo(unsigned w) { return __builtin_bit_cast(float, w << 16); }
__device__ __forceinline__ float bfhi(unsigned w) { return __builtin_bit_cast(float, w & 0xffff0000u); }
__device__ __forceinline__ float wave_sum(float v) {
#pragma unroll
    for (int o = 1; o < 64; o <<= 1) v += __shfl_xor(v, o);
    return v;
}
__device__ __forceinline__ int opaque_tid() { int t = threadIdx.x; asm volatile("" : "+v"(t)); return t; }
template <int CTRL> __device__ __forceinline__ float dpp_mov(float v) { return __builtin_bit_cast(float, __builtin_amdgcn_update_dpp(0, __builtin_bit_cast(int, v), CTRL, 0xf, 0xf, true)); }
__device__ __forceinline__ float sigmoidf_(float x) { return 1.f / (1.f + __expf(-x)); }
__device__ __forceinline__ float gelu_exact(float x) { return 0.5f * x * (1.f + erff(x * 0.70710678118654752f)); }

#define XB_TMO      128
#define XB_XCNT(j)  (256  + 64 * (j))
#define XB_XSUB(j)  (1280 + 64 * (j))
#define XB_XGEN(j)  (2304 + 64 * (j))
#define XB_TOP      3328
#define XB_TOPGEN   3392
#define XCD_BAR_WORDS 3456
#define XB_SPIN_CAP (1u << 18)

__device__ __forceinline__ unsigned xb_ld(unsigned* p)              { return __hip_atomic_load(p, __ATOMIC_RELAXED, __HIP_MEMORY_SCOPE_AGENT); }
__device__ __forceinline__ unsigned xb_add(unsigned* p, unsigned v) { return __hip_atomic_fetch_add(p, v, __ATOMIC_RELAXED, __HIP_MEMORY_SCOPE_AGENT); }
__device__ __forceinline__ unsigned xb_xcc_id() { return (unsigned)__builtin_amdgcn_s_getreg((3 << 11) | 20) & 0xFu; }
#define XB_SPIN(cond, bar) do { unsigned _sp = 0; while (cond) { __builtin_amdgcn_s_sleep(1); \
    if ((++_sp & 255u) == 0u) { if (xb_ld(&(bar)[XB_TMO])) break; if (_sp > XB_SPIN_CAP) { atomicAdd(&(bar)[XB_TMO], 1u); break; } } } } while (0)

struct XcdBarrier { unsigned* bar; unsigned x; volatile LAS unsigned* st; };

__device__ __forceinline__ XcdBarrier xcd_barrier_post(unsigned* bar, volatile LAS unsigned* st) {
    XcdBarrier b; b.bar = bar; b.x = xb_xcc_id(); b.st = st;
    if (threadIdx.x == 0) (void)xb_add(&bar[XB_XCNT(b.x)], 1u);
    return b;
}
__device__ __forceinline__ void xcd_barrier_complete(unsigned* bar, unsigned x, unsigned& nloc, unsigned& nx) {
    const unsigned G = gridDim.x * gridDim.y * gridDim.z;
    unsigned sum, cnt, mine, sp = 0u;
    for (;;) {
        sum = 0u; cnt = 0u; mine = 0u;
#pragma unroll
        for (unsigned j = 0; j < 16; ++j) { const unsigned c = xb_ld(&bar[XB_XCNT(j)]); sum += c; cnt += (c > 0u) ? 1u : 0u; mine = (j == x) ? c : mine; }
        if (sum == G) break;
        __builtin_amdgcn_s_sleep(1);
        if ((++sp & 255u) == 0u) { if (xb_ld(&bar[XB_TMO])) break; if (sp > XB_SPIN_CAP) { atomicAdd(&bar[XB_TMO], 1u); break; } }
    }
    nloc = mine > 0u ? mine : 1u; nx = cnt > 0u ? cnt : 1u;
}
__device__ __forceinline__ void xcd_barrier(const XcdBarrier& b) {
    asm volatile("s_waitcnt vmcnt(0)" ::: "memory");
    __syncthreads();
    if (threadIdx.x == 0) {
        unsigned* bar = b.bar;
        __builtin_amdgcn_s_waitcnt(0);
        unsigned nloc = b.st[0], nx = b.st[1];
        if (nloc == 0u) { xcd_barrier_complete(bar, b.x, nloc, nx); b.st[0] = nloc; b.st[1] = nx; }
        const unsigned old = xb_add(&bar[XB_XSUB(b.x)], 1u);
        const unsigned gen = old / nloc;
        if (old + 1u == (gen + 1u) * nloc) {
            __builtin_amdgcn_fence(__ATOMIC_RELEASE, "agent");
            asm volatile("s_waitcnt vmcnt(0)" ::: "memory");
            const unsigned og = xb_add(&bar[XB_TOP], 1u);
            const unsigned tg = og / nx;
            if (og + 1u == (tg + 1u) * nx) xb_add(&bar[XB_TOPGEN], 1u);
            else XB_SPIN(xb_ld(&bar[XB_TOPGEN]) == tg, bar);
            __builtin_amdgcn_fence(__ATOMIC_ACQUIRE, "agent");
            xb_add(&bar[XB_XGEN(b.x)], 1u);
            asm volatile("s_waitcnt vmcnt(0)" ::: "memory");
        } else {
            XB_SPIN(xb_ld(&bar[XB_XGEN(b.x)]) == gen, bar);
            __builtin_amdgcn_fence(__ATOMIC_ACQUIRE, "agent");
            asm volatile("s_waitcnt vmcnt(0)" ::: "memory");
        }
    }
    __syncthreads();
}

namespace pg8 {
constexpr int BM = 256, BK = 64, HALF = 128, HTB = HALF * BK * 2, STAGE_BYTES = 8 * HTB, NXCD = 8, WGM = 8;
__host__ __device__ __forceinline__ int lds_byte(int r, int c) { const int st = (r >> 4) * 2 + (c >> 5), rr = r & 15, cc = c & 31, ob = rr * 64 + cc * 2; return st * 1024 + (ob ^ (((ob >> 9) & 1) << 5)); }
__host__ __device__ __forceinline__ void stage_rc(int b, int& R, int& C) { const int st = b / 1024, sb = b % 1024, swz = sb ^ (((sb >> 9) & 1) << 5); R = (st >> 1) * 16 + swz / 64; C = (st & 1) * 32 + (swz % 64) / 2; }
__host__ __device__ __forceinline__ int perm32(int rho) { const int n = rho >> 4, i = rho & 15; return 8 * (i >> 2) + 4 * n + (i & 3); }

struct Unit { int pm, pn, seg; };
struct SegOrder {
    const bf16_t* A0; const bf16_t* B0; int nM0, nN0;
    const bf16_t* A1; const bf16_t* B1; int nM1, nN1;
    int G, c;
    __device__ __forceinline__ static void map(int L, int nM, int nN, int& pm, int& pn) {
        const int nwg = nM * nN; int wgid = L;
        { const int q = nwg / NXCD, r = nwg % NXCD, xcd = wgid % NXCD, off = wgid / NXCD; wgid = (xcd < r ? xcd * (q + 1) : r * (q + 1) + (xcd - r) * q) + off; }
        const int nig = WGM * nN, gid = wgid / nig, fm = gid * WGM, gsz = (nM - fm) < WGM ? (nM - fm) : WGM;
        pm = fm + ((wgid % nig) % gsz); pn = (wgid % nig) / gsz;
    }
    __device__ __forceinline__ bool next(int i, Unit& u) const {
        long L = (long)i * G + c; const int n0 = nM0 * nN0, n1 = nM1 * nN1;
        if (L < n0) { u.seg = 0; map((int)L, nM0, nN0, u.pm, u.pn); return true; }
        L -= n0;
        if (L < n1) { u.seg = 1; map((int)L, nM1, nN1, u.pm, u.pn); return true; }
        return false;
    }
    __device__ __forceinline__ const char* abase(const Unit& u) const { return (const char*)(u.seg ? A1 : A0); }
    __device__ __forceinline__ const char* bbase(const Unit& u) const { return (const char*)(u.seg ? B1 : B0); }
};

__device__ __forceinline__ unsigned cvt_pk_bf16(float lo, float hi) { unsigned r; asm volatile("v_cvt_pk_bf16_f32 %0, %1, %2" : "=v"(r) : "v"(lo), "v"(hi)); return r; }
__device__ __forceinline__ f32x2 gelu_pk(f32x2 v) {
    const f32x2 av = __builtin_elementwise_abs(v), d = av * 0.2316418882f + 1.0f;
    f32x2 t; t.x = __builtin_amdgcn_rcpf(d.x); t.y = __builtin_amdgcn_rcpf(d.y);
    f32x2 q = t * 0.5307027145f + (-0.7265760135f); q = q * t + 0.7107068705f; q = q * t + (-0.142248368f); q = q * t + 0.127414796f; q = q * t;
    const f32x2 s = (v * v) * (-0.72134752044f);
    f32x2 e; e.x = __builtin_amdgcn_exp2f(s.x); e.y = __builtin_amdgcn_exp2f(s.y);
    const f32x2 m = v * (q * e), r = v - m;
    f32x2 o; o.x = v.x < 0.f ? m.x : r.x; o.y = v.y < 0.f ? m.y : r.y; return o;
}
__device__ __forceinline__ float fast_sigmoid(float x) { return __builtin_amdgcn_rcpf(1.f + __builtin_amdgcn_exp2f(-1.4426950408889634f * x)); }

struct EpiInProj {
    bf16_t *PA, *PC, *PG, *PB;
    __device__ __forceinline__ void operator()(const f32x4 (&acc)[2][2][4][2], const Unit& u, int wr, int wc, int fr, int fq) const {
        const int row0 = u.pm * BM + wr * 64 + fr;
        int mode, ldc, colt; bf16_t* base;
        if (u.seg == 1) { mode = 0; ldc = M; colt = u.pn * BM; base = PB; }
        else if (u.pn < 8) { mode = 1; ldc = 2048; colt = u.pn * BM; base = PA; }
        else if (u.pn < 22) { mode = 0; ldc = CINP; colt = (u.pn - 8) * BM; base = PC; }
        else { mode = 2; ldc = 6144; colt = (u.pn - 22) * BM; base = PG; }
        const int col0 = colt + wc * 32 + 8 * fq;
#pragma unroll
        for (int ai = 0; ai < 2; ++ai)
#pragma unroll
            for (int m = 0; m < 4; ++m) { bf16_t* rowp = base + (size_t)(row0 + ai * HALF + m * 16) * ldc + col0;
#pragma unroll
                for (int bj = 0; bj < 2; ++bj) { f32x4 v0 = acc[ai][bj][m][0], v1 = acc[ai][bj][m][1];
                    if (mode == 1) { f32x2 a = gelu_pk((f32x2){v0[0], v0[1]}), b = gelu_pk((f32x2){v0[2], v0[3]}), c = gelu_pk((f32x2){v1[0], v1[1]}), d = gelu_pk((f32x2){v1[2], v1[3]});
                        v0 = (f32x4){a.x, a.y, b.x, b.y}; v1 = (f32x4){c.x, c.y, d.x, d.y}; }
                    else if (mode == 2) {
#pragma unroll
                        for (int j = 0; j < 4; ++j) { v0[j] = fast_sigmoid(v0[j]); v1[j] = fast_sigmoid(v1[j]); } }
                    u32x4 w; w.x = cvt_pk_bf16(v0[0], v0[1]); w.y = cvt_pk_bf16(v0[2], v0[3]); w.z = cvt_pk_bf16(v1[0], v1[1]); w.w = cvt_pk_bf16(v1[2], v1[3]);
                    *(u32x4*)(rowp + bj * HALF) = w; } }
    }
};
struct EpiBf16 {
    bf16_t* O; int ldc; size_t pn_stride; int pn_per;
    __device__ __forceinline__ void operator()(const f32x4 (&acc)[2][2][4][2], const Unit& u, int wr, int wc, int fr, int fq) const {
        const int row0 = u.pm * BM + wr * 64 + fr; const int tsel = u.pn / pn_per; const int col0 = (u.pn - tsel * pn_per) * BM + wc * 32 + 8 * fq;
        bf16_t* base = O + (size_t)tsel * pn_stride;
#pragma unroll
        for (int ai = 0; ai < 2; ++ai)
#pragma unroll
            for (int m = 0; m < 4; ++m) { bf16_t* rowp = base + (size_t)(row0 + ai * HALF + m * 16) * ldc + col0;
#pragma unroll
                for (int bj = 0; bj < 2; ++bj) { const f32x4 v0 = acc[ai][bj][m][0], v1 = acc[ai][bj][m][1];
                    u32x4 w; w.x = cvt_pk_bf16(v0[0], v0[1]); w.y = cvt_pk_bf16(v0[2], v0[3]); w.z = cvt_pk_bf16(v1[0], v1[1]); w.w = cvt_pk_bf16(v1[2], v1[3]);
                    *(u32x4*)(rowp + bj * HALF) = w; } }
    }
};
struct EpiSwiGlu {
    bf16_t* O; int ldc;
    __device__ __forceinline__ void operator()(const f32x4 (&acc)[2][2][4][2], const Unit& u, int wr, int wc, int fr, int fq) const {
        const int row0 = u.pm * BM + wr * 64 + fr; const int col0 = u.pn * HALF + wc * 32 + 8 * fq;
#pragma unroll
        for (int ai = 0; ai < 2; ++ai)
#pragma unroll
            for (int m = 0; m < 4; ++m) { bf16_t* rowp = O + (size_t)(row0 + ai * HALF + m * 16) * ldc + col0;
                f32x4 o0, o1;
#pragma unroll
                for (int j = 0; j < 4; ++j) { const float g0 = acc[ai][0][m][0][j], g1 = acc[ai][0][m][1][j];
                    o0[j] = g0 * fast_sigmoid(g0) * acc[ai][1][m][0][j]; o1[j] = g1 * fast_sigmoid(g1) * acc[ai][1][m][1][j]; }
                u32x4 w; w.x = cvt_pk_bf16(o0[0], o0[1]); w.y = cvt_pk_bf16(o0[2], o0[3]); w.z = cvt_pk_bf16(o1[0], o1[1]); w.w = cvt_pk_bf16(o1[2], o1[3]);
                *(u32x4*)rowp = w; }
    }
};
struct EpiResidual {
    float* X; int ldc;
    __device__ __forceinline__ void operator()(const f32x4 (&acc)[2][2][4][2], const Unit& u, int wr, int wc, int fr, int fq) const {
        const int row0 = u.pm * BM + wr * 64 + fr; const int col0 = u.pn * BM + wc * 32 + 8 * fq;
#pragma unroll
        for (int ai = 0; ai < 2; ++ai)
#pragma unroll
            for (int m = 0; m < 4; ++m) { float* rowp = X + (size_t)(row0 + ai * HALF + m * 16) * ldc + col0;
#pragma unroll
                for (int bj = 0; bj < 2; ++bj) { f32x4* p = (f32x4*)(rowp + bj * HALF); const f32x4 x0 = p[0], x1 = p[1];
                    p[0] = x0 + acc[ai][bj][m][0]; p[1] = x1 + acc[ai][bj][m][1]; } }
    }
};

template <class Epi>
__device__ __forceinline__ void gemm_phase(LAS unsigned char* lds, const int K, const SegOrder& S, const Epi& E) {
    int tid_ = threadIdx.x; asm volatile("" : "+v"(tid_));
    const int tid = tid_, wid = __builtin_amdgcn_readfirstlane(tid >> 6), lane = tid & 63, wr = wid >> 2, wc = wid & 3, fr = lane & 15, fq = lane >> 4;
    const int nt = K / BK;
    unsigned voffA[2], voffB[2];
#pragma unroll
    for (int i = 0; i < 2; ++i) { int R, C; stage_rc(tid * 16 + i * 8192, R, C); const int Rb = (R & ~31) + perm32(R & 31);
        voffA[i] = (unsigned)(R * K + C) * 2u; voffB[i] = (unsigned)(Rb * K + C) * 2u; }
    const size_t kstep = (size_t)(BK * 2);
    const size_t hstep = (size_t)HALF * K * 2;
    const size_t tstep = 2 * hstep;
    const unsigned ldsw = (unsigned)wid * 1024u;
    const int aoff = lds_byte(wr * 64 + fr, fq * 8), boff = lds_byte(wc * 32 + fr, fq * 8);
#define PG8_SA(b, h) (((b) * 2 + (h)) * HTB)
#define PG8_SB(b, h) ((4 + (b) * 2 + (h)) * HTB)
#define PG8_STAGE(bufoff, gbase, voff) do { _Pragma("unroll") for (int _i = 0; _i < 2; ++_i) \
        __builtin_amdgcn_global_load_lds((const unsigned*)((const char*)(gbase) + (voff)[_i]), (LAS unsigned*)(lds + (bufoff) + ldsw + _i * 8192), 16, 0, 0); } while (0)
#define PG8_LDA(dst, b, h) do { _Pragma("unroll") for (int m = 0; m < 4; ++m) _Pragma("unroll") for (int k = 0; k < 2; ++k) dst[m][k] = *(const LAS bf16x8*)(lds + PG8_SA(b, h) + aoff + m * 2048 + k * 1024); } while (0)
#define PG8_LDB(dst, b, h) do { _Pragma("unroll") for (int n = 0; n < 2; ++n) _Pragma("unroll") for (int k = 0; k < 2; ++k) dst[n][k] = *(const LAS bf16x8*)(lds + PG8_SB(b, h) + boff + n * 2048 + k * 1024); } while (0)
#define PG8_MMA(ai, bj, At, Bt) do { __builtin_amdgcn_s_setprio(1); _Pragma("unroll") for (int m = 0; m < 4; ++m) _Pragma("unroll") for (int n = 0; n < 2; ++n) _Pragma("unroll") for (int k = 0; k < 2; ++k) \
        acc[ai][bj][m][n] = __builtin_amdgcn_mfma_f32_16x16x32_bf16(Bt[n][k], At[m][k], acc[ai][bj][m][n], 0, 0, 0); __builtin_amdgcn_s_setprio(0); } while (0)
#define PG8_WAIT_V(n) asm volatile("s_waitcnt vmcnt(" #n ")" ::: "memory")
#define PG8_WAIT_L(n) asm volatile("s_waitcnt lgkmcnt(" #n ")" ::: "memory")
#define PG8_BAR __builtin_amdgcn_s_barrier()
#define PG8_SCHED __builtin_amdgcn_sched_barrier(0)
    Unit cur, nxt; int ui = 0;
    if (!S.next(0, cur)) return;
    f32x4 acc[2][2][4][2];
#pragma unroll
    for (int a = 0; a < 2; ++a)
#pragma unroll
        for (int b = 0; b < 2; ++b)
#pragma unroll
            for (int m = 0; m < 4; ++m)
#pragma unroll
                for (int n = 0; n < 2; ++n) acc[a][b][m][n] = (f32x4){0.f, 0.f, 0.f, 0.f};
    bf16x8 At[4][2], B0[2][2], B1[2][2];
    const char* cA = S.abase(cur) + (size_t)cur.pm * tstep; const char* cB = S.bbase(cur) + (size_t)cur.pn * tstep;
    PG8_STAGE(PG8_SB(0, 0), cB, voffB); PG8_STAGE(PG8_SB(0, 1), cB + hstep, voffB); PG8_STAGE(PG8_SA(0, 0), cA, voffA); PG8_STAGE(PG8_SA(0, 1), cA + hstep, voffA);
    if (wr == 1) PG8_BAR;
    PG8_WAIT_V(2); PG8_BAR;
    PG8_STAGE(PG8_SB(1, 0), cB + kstep, voffB); PG8_STAGE(PG8_SA(1, 0), cA + kstep, voffA); PG8_STAGE(PG8_SB(1, 1), cB + hstep + kstep, voffB);
    PG8_WAIT_V(6); PG8_BAR;
    for (;;) {
        const bool has_next = S.next(ui + 1, nxt);
        const char* nA = has_next ? S.abase(nxt) + (size_t)nxt.pm * tstep : cA; const char* nB = has_next ? S.bbase(nxt) + (size_t)nxt.pn * tstep : cB;
        for (int t = 0; t < nt; t += 2) {
            const bool last = (t == nt - 2);
            const char* a1 = cA + (size_t)(t + 1) * kstep;
            const char* a2 = last ? nA : cA + (size_t)(t + 2) * kstep; const char* b2 = last ? nB : cB + (size_t)(t + 2) * kstep;
            const char* a3 = a2 + kstep; const char* b3 = b2 + kstep;
            PG8_LDB(B0, 0, 0); PG8_LDB(B1, 0, 1); PG8_SCHED; PG8_LDA(At, 0, 0); PG8_STAGE(PG8_SA(1, 1), a1 + hstep, voffA);
            PG8_WAIT_V(8); PG8_WAIT_L(0); PG8_BAR; PG8_MMA(0, 0, At, B0); PG8_MMA(0, 1, At, B1); PG8_BAR; PG8_SCHED;
            PG8_LDA(At, 0, 1); PG8_STAGE(PG8_SB(0, 0), b2, voffB); PG8_STAGE(PG8_SB(0, 1), b2 + hstep, voffB); PG8_STAGE(PG8_SA(0, 0), a2, voffA);
            PG8_WAIT_V(8); PG8_WAIT_L(0); PG8_BAR; PG8_MMA(1, 0, At, B0); PG8_MMA(1, 1, At, B1); PG8_BAR; PG8_SCHED;
            PG8_LDB(B0, 1, 0); PG8_LDB(B1, 1, 1); PG8_SCHED; PG8_LDA(At, 1, 0); PG8_STAGE(PG8_SA(0, 1), a2 + hstep, voffA);
            PG8_WAIT_V(8); PG8_WAIT_L(0); PG8_BAR; PG8_MMA(0, 0, At, B0); PG8_MMA(0, 1, At, B1); PG8_BAR; PG8_SCHED;
            PG8_LDA(At, 1, 1); PG8_STAGE(PG8_SB(1, 0), b3, voffB); PG8_STAGE(PG8_SB(1, 1), b3 + hstep, voffB); PG8_STAGE(PG8_SA(1, 0), a3, voffA);
            PG8_WAIT_V(8); PG8_WAIT_L(0); PG8_BAR; PG8_MMA(1, 0, At, B0); PG8_MMA(1, 1, At, B1); PG8_BAR; PG8_SCHED;
        }
        if (wr == 0) PG8_BAR;
        E(acc, cur, wr, wc, fr, fq);
        if (!has_next) break;
#pragma unroll
        for (int a = 0; a < 2; ++a)
#pragma unroll
            for (int b = 0; b < 2; ++b)
#pragma unroll
                for (int m = 0; m < 4; ++m)
#pragma unroll
                    for (int n = 0; n < 2; ++n) acc[a][b][m][n] = (f32x4){0.f, 0.f, 0.f, 0.f};
        cur = nxt; cA = nA; cB = nB; ++ui;
        if (wr == 1) PG8_BAR;
    }
    PG8_WAIT_V(0);
    PG8_BAR;
#undef PG8_SA
#undef PG8_SB
#undef PG8_STAGE
#undef PG8_LDA
#undef PG8_LDB
#undef PG8_MMA
#undef PG8_WAIT_V
#undef PG8_WAIT_L
#undef PG8_BAR
#undef PG8_SCHED
}
}

struct Args { const float* in[N_INPUTS]; float* out; unsigned char* ws; int ph_lo, ph_hi; };
constexpr int PTAB_OFF = LDS_MISC_OFF + 256;
struct PT {
    LAS unsigned char* lds;
    __device__ __forceinline__ unsigned long long raw(int i) const { const u32x2 v = *(const LAS u32x2*)(lds + PTAB_OFF + 8 * i);
        return ((unsigned long long)(unsigned)__builtin_amdgcn_readfirstlane((int)v.y) << 32) | (unsigned long long)(unsigned)__builtin_amdgcn_readfirstlane((int)v.x); }
    __device__ __forceinline__ const float* in(int i) const { return (const float*)raw(i); }
    __device__ __forceinline__ float* out() const { return (float*)raw(N_INPUTS); }
    __device__ __forceinline__ unsigned char* ws() const { return (unsigned char*)raw(N_INPUTS + 1); }
};

__device__ __forceinline__ void transpose_item(const float* W, int Nsrc, int k0, int n0, bf16_t* WT, int Kd, int drow0, LAS float* scr, int lane) {
#pragma unroll 8
    for (int i = 0; i < 32; ++i) { const int kk = 2 * i + (lane >> 5); scr[kk * 33 + (lane & 31)] = W[(size_t)(k0 + kk) * Nsrc + n0 + (lane & 31)]; }
    asm volatile("s_waitcnt lgkmcnt(0)" ::: "memory");
    const int c = lane & 7;
#pragma unroll
    for (int j = 0; j < 4; ++j) { const int n = (lane >> 3) + 8 * j; const LAS float* s = scr + (8 * c) * 33 + n;
        u32x4 o; o.x = pk2(s[0 * 33], s[1 * 33]); o.y = pk2(s[2 * 33], s[3 * 33]); o.z = pk2(s[4 * 33], s[5 * 33]); o.w = pk2(s[6 * 33], s[7 * 33]);
        *(u32x4*)(WT + (size_t)(drow0 + n) * Kd + k0 + 8 * c) = o; }
    asm volatile("s_waitcnt lgkmcnt(0)" ::: "memory");
}

constexpr int IT_WIN = 32 * 458, IT_BR = 16 * 64, IT_OUT = 32 * 64, IT_GU = 32 * 176, IT_DN = 88 * 64;
constexpr int IT_LAYER = IT_WIN + 3 * IT_BR + IT_OUT + 2 * IT_GU + IT_DN;

__device__ __forceinline__ void prologue_a(const PT& a, LAS unsigned char* lds) {
    unsigned char* ws = a.ws();
    const int tid = opaque_tid(), lane = tid & 63, wave = tid >> 6;
    const int gw = blockIdx.x * NWAVES + wave, NGW = gridDim.x * NWAVES;
    const size_t gt = (size_t)blockIdx.x * NTHREADS + tid, NGT = (size_t)gridDim.x * NTHREADS;
    { const f32x4* src = (const f32x4*)a.in(I_X); f32x4* dst = (f32x4*)(ws + WS_X);
      for (size_t i = gt; i < (size_t)M * D / 4; i += NGT) dst[i] = src[i]; }
    { for (int l = 0; l < DEPTH; ++l) { u32x4* p = (u32x4*)(ws + WS_WIN + l * WIN_L + (size_t)5440 * D * 2); const size_t n = (size_t)192 * D * 2 / 16;
        for (size_t i = gt; i < n; i += NGT) p[i] = (u32x4){0u, 0u, 0u, 0u}; } }
    LAS float* scr = (LAS float*)(lds + wave * 16384);
    for (int it = gw; it < DEPTH * IT_LAYER; it += NGW) {
        const int l = it / IT_LAYER; int r = it - l * IT_LAYER;
        if (r < IT_WIN) { const int kb = r / 458, nb = r % 458, n0 = nb * 32;
            int drow; if (n0 < 2048) drow = n0; else if (n0 < 5120) drow = NIN_MAIN + (n0 - 2048); else if (n0 < 8512) drow = 2048 + (n0 - 5120); else drow = 5632 + (n0 - 8512);
            transpose_item(a.in(I_W_IN) + (size_t)l * D * NIN, NIN, kb * 64, n0, (bf16_t*)(ws + WS_WIN + l * WIN_L), D, drow, scr, lane); continue; }
        r -= IT_WIN;
        if (r < 3 * IT_BR) { const int br = r / IT_BR; r -= br * IT_BR; const int kb = r / 64, nb = r % 64;
            const float* src = a.in(br == 0 ? I_W_BR_A : (br == 1 ? I_W_BR_B : I_W_BR_C)) + (size_t)l * 1024 * D;
            transpose_item(src, D, kb * 64, nb * 32, (bf16_t*)(ws + WS_WBR + l * WBR_L) + (size_t)br * D * 1024, 1024, nb * 32, scr, lane); continue; }
        r -= 3 * IT_BR;
        if (r < IT_OUT) { const int kb = r / 64, nb = r % 64;
            transpose_item(a.in(I_W_OUT) + (size_t)l * D * D, D, kb * 64, nb * 32, (bf16_t*)(ws + WS_WOUT + l * WOUT_L), D, nb * 32, scr, lane); continue; }
        r -= IT_OUT;
        if (r < 2 * IT_GU) { const int up = r / IT_GU; r -= up * IT_GU; const int kb = r / 176, nb = r % 176, n0 = nb * 32;
            const float* src = a.in(up ? I_W_FFN_UP : I_W_FFN_GATE) + (size_t)l * D * DFF;
            transpose_item(src, DFF, kb * 64, n0, (bf16_t*)(ws + WS_WGU + l * WGU_L), D, 256 * (n0 / 128) + (n0 % 128) + 128 * up, scr, lane); continue; }
        r -= 2 * IT_GU;
        { const int kb = r / 64, nb = r % 64;
            transpose_item(a.in(I_W_FFN_DOWN) + (size_t)l * DFF * D, D, kb * 64, nb * 32, (bf16_t*)(ws + WS_WDN + l * WDN_L), DFF, nb * 32, scr, lane); }
    }
    { bf16_t* WL = (bf16_t*)(ws + WS_WLORA);
      for (size_t i = gt; i < (size_t)DEPTH * 1024 * LORA_K; i += NGT) { const int l = (int)(i / (1024 * LORA_K)); const int rem = (int)(i - (size_t)l * 1024 * LORA_K); const int ch = rem / LORA_K, k = rem - ch * LORA_K;
          float v = 0.f;
          if (k < 256) { const int seg = k >> 6, r = k & 63, d = seg & 1; if (r < 48) v = (seg < 2 ? a.in(I_RW_W2) : a.in(I_RW_A2))[(((size_t)l * 2 + d) * 48 + r) * 1024 + ch]; }
          else if (k < 384) v = a.in(I_RW_G2)[((size_t)l * GL + (k - 256)) * 1024 + ch];
          else if (l > 0) v = a.in(I_RW_V2)[((size_t)(l - 1) * VL + (k - 384)) * 1024 + ch];
          WL[i] = (bf16_t)f2bf(v); }
      bf16_t* V1T = (bf16_t*)(ws + WS_V1T);
      for (size_t i = gt; i < (size_t)3 * 32 * 1024; i += NGT) { const int l1 = (int)(i >> 15), r = (int)(i >> 10) & 31, c = (int)(i & 1023);
          V1T[i] = (bf16_t)f2bf(a.in(I_RW_V1)[((size_t)l1 * 1024 + c) * VL + r]); } }
    for (int row = gw; row < DEPTH * T; row += NGW) {
        const int l = row / T, t = row % T, j = lane;
        float f = 0.f;
        if (lane == 0) f = (float)t / (float)(T - 1);
        else if (lane < HYE) { const int m = (lane - 1) & 15; const float fr = 1e-4f + (float)m * ((15.0f - 1e-4f) / 15.0f);
            const float ang = (6.283185307179586f / (float)T) * (float)t * fr; f = (lane <= 16) ? cosf(ang) : -sinf(ang); }
        const float fq = a.in(I_HY_FREQ)[l * HYF + j];
        float acc = a.in(I_HY_B1)[l * HYF + j];
        { const float* w = a.in(I_HY_W1) + (size_t)l * HYE * HYF;
          for (int i = 0; i < HYE; ++i) acc += __shfl(f, i) * w[i * HYF + j]; }
        float z = sinf(fq * acc);
        acc = a.in(I_HY_B2)[l * HYF + j];
        { const float* w = a.in(I_HY_W2) + (size_t)l * HYF * HYF;
          for (int i = 0; i < HYF; ++i) acc += __shfl(z, i) * w[i * HYF + j]; }
        z = sinf(fq * acc);
        acc = a.in(I_HY_B3)[l * HYF + j];
        { const float* w = a.in(I_HY_W3) + (size_t)l * HYF * HYF;
          for (int i = 0; i < HYF; ++i) acc += __shfl(z, i) * w[i * HYF + j]; }
        z = sinf(fq * acc);
        ((float*)(ws + WS_Z3))[(size_t)row * HYF + j] = z;
    }
}

__device__ __forceinline__ void prologue_b(const PT& a, LAS unsigned char* lds) {
    unsigned char* ws = a.ws();
    const int tid = opaque_tid(), lane = tid & 63, wave = tid >> 6;
    LAS float* w4s = (LAS float*)lds;
    LAS float* dec = w4s + 1024;
    LAS float* red = dec + 16;
    LAS float* inv = red + 128;
    for (int u = blockIdx.x; u < DEPTH * 2 * 128; u += gridDim.x) {
        const int l = u >> 8, o = (u >> 7) & 1, c0 = (u & 127) * 8;
        __syncthreads();
        for (int e = tid; e < 1024; e += NTHREADS) { const int j = e >> 4, q = e & 15, dir = q >> 3, cl = q & 7;
            w4s[q * 64 + j] = a.in(I_HY_W4)[((size_t)l * HYF + j) * 4096 + dir * 2048 + o * 1024 + c0 + cl]; }
        if (tid < 16) { const int dir = tid >> 3, cl = tid & 7; dec[tid] = expf(a.in(I_HY_LOG_DECAY)[(((size_t)l * 2 + dir) * 2 + o) * 1024 + c0 + cl]); }
        __syncthreads();
        float* hf = (float*)(ws + WS_HF) + (((size_t)l * 2 + o) * 1024 + c0) * 4096;
        if (tid < 128) red[tid] = 0.f;
        __syncthreads();
#pragma unroll 1
        for (int i = 0; i < 4; ++i) {
            const int t = tid + NTHREADS * i; const float tn = (float)t / (float)(T - 1);
            f32x4 z[16]; const f32x4* zp = (const f32x4*)((const float*)(ws + WS_Z3) + ((size_t)l * T + t) * HYF);
#pragma unroll
            for (int j = 0; j < 16; ++j) z[j] = zp[j];
#pragma unroll 1
            for (int q = 0; q < 16; ++q) { const int dir = q >> 3, cl = q & 7; const LAS f32x4* wq = (const LAS f32x4*)(w4s + q * 64);
                float acc = 0.f;
#pragma unroll
                for (int j = 0; j < 16; ++j) { const f32x4 w = wq[j]; acc += z[j][0] * w[0]; acc += z[j][1] * w[1]; acc += z[j][2] * w[2]; acc += z[j][3] * w[3]; }
                const float h = acc * expf(-tn * dec[q]);
                const float s = wave_sum(fabsf(h));
                if (lane == 0) red[wave * 16 + q] += s;
                if (dir == 0) hf[(size_t)cl * 4096 + 2048 + t] = h; else if (t >= 1) hf[(size_t)cl * 4096 + 2048 - t] = h; }
        }
        __syncthreads();
        if (tid < 8) { float s = 0.f; for (int w = 0; w < 8; ++w) s += red[w * 16 + tid] + red[w * 16 + 8 + tid]; inv[tid] = 1.f / s; }
        __syncthreads();
        for (int i = 0; i < 4; ++i) {
            const int t = tid + NTHREADS * i;
#pragma unroll
            for (int cl = 0; cl < 8; ++cl) { const float s = inv[cl];
                hf[(size_t)cl * 4096 + 2048 + t] *= s; if (t >= 1) hf[(size_t)cl * 4096 + 2048 - t] *= s; }
        }
        if (tid < 8) hf[(size_t)tid * 4096] = 0.f;
    }
}

__device__ __forceinline__ void rmsnorm_phase(const float* X, const float* g, bf16_t* Hb, float* Of) {
    const int tid = opaque_tid(), lane = tid & 63, wave = tid >> 6;
    const int gw = blockIdx.x * NWAVES + wave, NGW = gridDim.x * NWAVES;
    for (int m = gw; m < M; m += NGW) {
        const f32x4* xr = (const f32x4*)(X + (size_t)m * D) + lane;
        f32x4 v[8]; float s = 0.f;
#pragma unroll
        for (int j = 0; j < 8; ++j) { v[j] = xr[64 * j]; s += (v[j][0] * v[j][0] + v[j][1] * v[j][1]) + (v[j][2] * v[j][2] + v[j][3] * v[j][3]); }
        const float rstd = 1.f / sqrtf(wave_sum(s) * (1.f / D) + RMS_EPS);
#pragma unroll
        for (int j = 0; j < 8; ++j) { const f32x4 gv = ((const f32x4*)g)[lane + 64 * j]; const f32x4 y = v[j] * rstd * gv;
            if (Of) ((f32x4*)(Of + (size_t)m * D))[lane + 64 * j] = y;
            else { u32x2 o; o.x = pk2(y[0], y[1]); o.y = pk2(y[2], y[3]); ((u32x2*)(Hb + (size_t)m * D))[lane + 64 * j] = o; } }
    }
}

__device__ __forceinline__ void gmlp_stats_phase(const bf16_t* PA, float* stats) {
    const int tid = opaque_tid(), lane = tid & 63, wave = tid >> 6;
    const int gw = blockIdx.x * NWAVES + wave, NGW = gridDim.x * NWAVES;
    for (int m = gw; m < M; m += NGW) {
        const u32x4* p = (const u32x4*)(PA + (size_t)m * 2048 + 1024) + lane * 2;
        const u32x4 a = p[0], b = p[1];
        float v[16];
#pragma unroll
        for (int j = 0; j < 4; ++j) { v[2 * j] = bflo(a[j]); v[2 * j + 1] = bfhi(a[j]); v[8 + 2 * j] = bflo(b[j]); v[8 + 2 * j + 1] = bfhi(b[j]); }
        float s = 0.f;
#pragma unroll
        for (int j = 0; j < 16; ++j) s += v[j];
        const float mu = wave_sum(s) * (1.f / 1024.f); float s2 = 0.f;
#pragma unroll
        for (int j = 0; j < 16; ++j) { const float d = v[j] - mu; s2 += d * d; }
        const float rstd = 1.f / sqrtf(wave_sum(s2) * (1.f / 1024.f) + LN_EPS);
        if (lane == 0) { stats[2 * m] = mu; stats[2 * m + 1] = rstd; }
    }
}

__device__ __forceinline__ void gmlp_unit(const PT& a, int l, int u, LAS unsigned char* lds) {
    unsigned char* ws = a.ws();
    const int tid = opaque_tid();
    const int g = u & 7, ck = u >> 3;
    const int tok0 = ck * CHUNK;
    LAS float* vn = (LAS float*)lds;
    LAS float* wsT = vn + 128 * 128;
    const bf16_t* PA = (const bf16_t*)(ws + WS_PA); const float* stats = (const float*)(ws + WS_STATS);
    const float* lng = a.in(I_GM_LN_G) + l * AW + g * 128; const float* lnb = a.in(I_GM_LN_B) + l * AW + g * 128;
    __syncthreads();
    for (int e = tid; e < 128 * 128; e += NTHREADS) { const int q = e >> 7, d = e & 127;
        const float x = bf2f(PA[(size_t)(tok0 + q) * 2048 + 1024 + g * 128 + d]);
        vn[e] = (x - stats[2 * (tok0 + q)]) * stats[2 * (tok0 + q) + 1] * lng[d] + lnb[d]; }
    { const float* wsrc = a.in(I_GM_WS) + ((size_t)l * AG + g) * 128 * 128;
      for (int e = tid; e < 128 * 128; e += NTHREADS) { const int p = e >> 7, q = e & 127; wsT[q * 128 + p] = wsrc[e]; } }
    __syncthreads();
    const int dg = tid & 31, pg = tid >> 5;
    float acc[8][4];
#pragma unroll
    for (int i = 0; i < 8; ++i)
#pragma unroll
        for (int j = 0; j < 4; ++j) acc[i][j] = 0.f;
    for (int q = 0; q < 128; ++q) {
        const f32x4 vv = *(const LAS f32x4*)(vn + q * 128 + 4 * dg);
        const f32x4 w0 = *(const LAS f32x4*)(wsT + q * 128 + 8 * pg), w1 = *(const LAS f32x4*)(wsT + q * 128 + 8 * pg + 4);
#pragma unroll
        for (int j = 0; j < 4; ++j) {
#pragma unroll
            for (int i = 0; i < 4; ++i) { acc[i][j] += w0[i] * vv[j]; acc[4 + i][j] += w1[i] * vv[j]; } }
    }
    const float* bs = a.in(I_GM_BS) + ((size_t)l * AG + g) * 128;
    bf16_t* YA = (bf16_t*)(ws + WS_YA);
#pragma unroll
    for (int i = 0; i < 8; ++i) { const int p = 8 * pg + i; const float bb = bs[p];
        const u32x2 uu = *(const u32x2*)(PA + (size_t)(tok0 + p) * 2048 + g * 128 + 4 * dg);
        const float y0 = bflo(uu.x) * (acc[i][0] + bb), y1 = bfhi(uu.x) * (acc[i][1] + bb), y2 = bflo(uu.y) * (acc[i][2] + bb), y3 = bfhi(uu.y) * (acc[i][3] + bb);
        u32x2 o; o.x = pk2(y0, y1); o.y = pk2(y2, y3);
        *(u32x2*)(YA + (size_t)(tok0 + p) * 1024 + g * 128 + 4 * dg) = o; }
}

__device__ __forceinline__ float hy_cv(const bf16_t* row, int t, float w0, float w1, float w2, float cb) {
    const float c = bf2f(row[t]); const float p = t > 0 ? bf2f(row[t - 1]) : 0.f; const float n = t < T - 1 ? bf2f(row[t + 1]) : 0.f;
    return w0 * p + w1 * c + w2 * n + cb;
}
__device__ __forceinline__ void hyena_unit(const PT& a, int l, int c, LAS unsigned char* lds) {
    unsigned char* ws = a.ws();
    const int tid = opaque_tid();
    LAS float* taps = (LAS float*)lds;
    LAS float* zin = taps + 4096;
    const bf16_t* PB = (const bf16_t*)(ws + WS_PB);
    const float* cw = a.in(I_HY_CONV_W) + (size_t)l * 3 * 3072; const float* cb = a.in(I_HY_CONV_B) + (size_t)l * 3072;
    const float* hf = (const float*)(ws + WS_HF) + (((size_t)l * 2 + 0) * 1024 + c) * 4096;
    const float bd0 = a.in(I_HY_BIAS_D)[(l * 2 + 0) * 1024 + c], bd1 = a.in(I_HY_BIAS_D)[(l * 2 + 1) * 1024 + c];
    __syncthreads();
    for (int e = tid; e < 4096; e += NTHREADS) taps[e] = hf[e];
    { const int ch = 2048 + c; const float w0 = cw[ch], w1 = cw[3072 + ch], w2 = cw[2 * 3072 + ch], b0 = cb[ch];
      for (int e = tid; e < T * 4; e += NTHREADS) { const int b = e >> 11, t = e & (T - 1); zin[t * 4 + b] = hy_cv(PB + (size_t)ch * M + b * T, t, w0, w1, w2, b0); } }
    __syncthreads();
    float acc[4][4];
#pragma unroll
    for (int order = 0; order < 2; ++order) {
#pragma unroll
        for (int i = 0; i < 4; ++i)
#pragma unroll
            for (int b = 0; b < 4; ++b) acc[i][b] = 0.f;
        for (int s = 0; s < T; ++s) {
            const f32x4 zv = *(const LAS f32x4*)(zin + s * 4);
#pragma unroll
            for (int i = 0; i < 4; ++i) { const float k = taps[tid + NTHREADS * i - s + 2048];
#pragma unroll
                for (int b = 0; b < 4; ++b) acc[i][b] += k * zv[b]; }
        }
        const float bd = order == 0 ? bd0 : bd1;
#pragma unroll
        for (int i = 0; i < 4; ++i) { const f32x4 zv = *(const LAS f32x4*)(zin + (tid + NTHREADS * i) * 4);
#pragma unroll
            for (int b = 0; b < 4; ++b) acc[i][b] += bd * zv[b]; }
        __syncthreads();
        const int ch = order == 0 ? c : 1024 + c;
        const float w0 = cw[ch], w1 = cw[3072 + ch], w2 = cw[2 * 3072 + ch], b0 = cb[ch];
        if (order == 0) {
#pragma unroll
            for (int i = 0; i < 4; ++i) { const int t = tid + NTHREADS * i; f32x4 o;
#pragma unroll
                for (int b = 0; b < 4; ++b) o[b] = acc[i][b] * hy_cv(PB + (size_t)ch * M + b * T, t, w0, w1, w2, b0);
                *(LAS f32x4*)(zin + t * 4) = o; }
            for (int e = tid; e < 4096; e += NTHREADS) taps[e] = hf[(size_t)1024 * 4096 + e];
            __syncthreads();
        } else {
            bf16_t* YB = (bf16_t*)(ws + WS_YB);
#pragma unroll
            for (int i = 0; i < 4; ++i) { const int t = tid + NTHREADS * i;
#pragma unroll
                for (int b = 0; b < 4; ++b) YB[(size_t)(b * T + t) * 1024 + c] = (bf16_t)f2bf(acc[i][b] * hy_cv(PB + (size_t)ch * M + b * T, t, w0, w1, w2, b0)); }
        }
    }
}

typedef float f32x16 __attribute__((ext_vector_type(16)));
constexpr int HYK_OFF = 0, HYZ_OFF = 65536, HYZ_PITCH = 320, HYT_OFF = HYZ_OFF + 25088;
__device__ __forceinline__ void hy_cv4(const bf16_t* row, int t0, float w0, float w1, float w2, float cb, float (&o)[4]) {
    const u32x2 x = *(const u32x2*)(row + t0);
    const float xm = t0 > 0 ? bf2f(row[t0 - 1]) : 0.f, xp = t0 + 4 < T ? bf2f(row[t0 + 4]) : 0.f;
    const float x0 = bflo(x.x), x1 = bfhi(x.x), x2 = bflo(x.y), x3 = bfhi(x.y);
    o[0] = w0 * xm + w1 * x0 + w2 * x1 + cb; o[1] = w0 * x0 + w1 * x1 + w2 * x2 + cb; o[2] = w0 * x1 + w1 * x2 + w2 * x3 + cb; o[3] = w0 * x2 + w1 * x3 + w2 * xp + cb;
}
__device__ __forceinline__ void hy_build_taps(LAS unsigned char* lds, const float* hf, int tid) {
    LAS float* tapf = (LAS float*)(lds + HYT_OFF);
    for (int e = tid; e < 1024; e += NTHREADS) *(LAS f32x4*)(tapf + 4 * e) = *(const f32x4*)(hf + 4 * e);
    __syncthreads();
#pragma unroll
    for (int i = 0; i < 8; ++i) { const int uid = tid + NTHREADS * i, yq = uid >> 3, sg = uid & 7; const int i0 = 4096 - 8 * yq + sg;
        float v[8];
#pragma unroll
        for (int e = 0; e < 8; ++e) { const int idx = i0 - e; v[e] = idx < 4096 ? tapf[idx] : 0.f; }
        u32x4 o; o.x = pk2(v[0], v[1]); o.y = pk2(v[2], v[3]); o.z = pk2(v[4], v[5]); o.w = pk2(v[6], v[7]);
        *(LAS u32x4*)(lds + HYK_OFF + uid * 16) = o; }
    __syncthreads();
}
__device__ __forceinline__ void hy_conv_mfma(LAS unsigned char* lds, int i0, int lane, f32x16& acc) {
    const int j = lane & 31, hh = lane >> 5, jq = j >> 3, jr = j & 7, bl = j >> 2, b = j & 3;
    const int dmin = i0 - 63;
    const LAS unsigned char* ap = lds + HYK_OFF + (256 - 4 * dmin - jq + hh) * 128 + jr * 16;
    const LAS unsigned char* bp = lds + HYZ_OFF + (i0 + bl - dmin + 7) * HYZ_PITCH + hh * 64 + b * 16;
#pragma unroll 2
    for (int d = 0; d < 71; ++d) {
        const bf16x8 a0 = *(const LAS bf16x8*)(ap), a1 = *(const LAS bf16x8*)(ap + 256);
        const bf16x8 b0 = *(const LAS bf16x8*)(bp), b1 = *(const LAS bf16x8*)(bp + 128);
        acc = __builtin_amdgcn_mfma_f32_32x32x16_bf16(a0, b0, acc, 0, 0, 0);
        acc = __builtin_amdgcn_mfma_f32_32x32x16_bf16(a1, b1, acc, 0, 0, 0);
        ap -= 512; bp -= HYZ_PITCH;
    }
}
__device__ __forceinline__ void hyena_unit2(const PT& a, int l, int c, LAS unsigned char* lds) {
    unsigned char* ws = a.ws();
    const int tid = opaque_tid(), lane = tid & 63, wave = __builtin_amdgcn_readfirstlane(tid >> 6);
    const bf16_t* PB = (const bf16_t*)(ws + WS_PB);
    const float* cw = a.in(I_HY_CONV_W) + (size_t)l * 3 * 3072; const float* cb = a.in(I_HY_CONV_B) + (size_t)l * 3072;
    const float* hf = (const float*)(ws + WS_HF) + (((size_t)l * 2 + 0) * 1024 + c) * 4096;
    const float bd0 = a.in(I_HY_BIAS_D)[(l * 2 + 0) * 1024 + c], bd1 = a.in(I_HY_BIAS_D)[(l * 2 + 1) * 1024 + c];
    __syncthreads();
    { const int ch = 2048 + c; const float w0 = cw[ch], w1 = cw[3072 + ch], w2 = cw[2 * 3072 + ch], b0 = cb[ch];
      for (int e = tid; e < 2 * 7 * HYZ_PITCH / 4; e += NTHREADS) { const int off = e * 4; ((LAS unsigned*)(lds + HYZ_OFF + (off < 7 * HYZ_PITCH ? off : off + 64 * HYZ_PITCH)))[0] = 0u; }
#pragma unroll
      for (int i = 0; i < 4; ++i) { const int e = tid + NTHREADS * i, b = e >> 9, t0 = (e & 511) * 4; float o[4];
          hy_cv4(PB + (size_t)ch * M + b * T, t0, w0, w1, w2, b0, o);
          u32x2 pk; pk.x = pk2(o[0], o[1]); pk.y = pk2(o[2], o[3]);
          *(LAS u32x2*)(lds + HYZ_OFF + ((t0 >> 5) + 7) * HYZ_PITCH + ((t0 >> 3) & 3) * 64 + b * 16 + (t0 & 7) * 2) = pk; } }
    hy_build_taps(lds, hf, tid);
    const int i0 = wave * 8, n = lane & 31, hh = lane >> 5, bl = n >> 2, b = n & 3, blk = i0 + bl;
    float zf[16];
    {   f32x16 acc;
#pragma unroll
        for (int r = 0; r < 16; ++r) acc[r] = 0.f;
        hy_conv_mfma(lds, i0, lane, acc);
        const float w0 = cw[c], w1 = cw[3072 + c], w2 = cw[2 * 3072 + c], b0 = cb[c];
#pragma unroll
        for (int g = 0; g < 4; ++g) { const int t0 = 32 * blk + 8 * g + 4 * hh;
            const u32x2 zo = *(const LAS u32x2*)(lds + HYZ_OFF + (blk + 7) * HYZ_PITCH + g * 64 + b * 16 + 8 * hh);
            float x1[4]; hy_cv4(PB + (size_t)c * M + b * T, t0, w0, w1, w2, b0, x1);
            zf[4 * g + 0] = x1[0] * (acc[4 * g + 0] + bd0 * bflo(zo.x)); zf[4 * g + 1] = x1[1] * (acc[4 * g + 1] + bd0 * bfhi(zo.x));
            zf[4 * g + 2] = x1[2] * (acc[4 * g + 2] + bd0 * bflo(zo.y)); zf[4 * g + 3] = x1[3] * (acc[4 * g + 3] + bd0 * bfhi(zo.y)); }
    }
    __syncthreads();
#pragma unroll
    for (int g = 0; g < 4; ++g) { u32x2 pk; pk.x = pk2(zf[4 * g], zf[4 * g + 1]); pk.y = pk2(zf[4 * g + 2], zf[4 * g + 3]);
        *(LAS u32x2*)(lds + HYZ_OFF + (blk + 7) * HYZ_PITCH + g * 64 + b * 16 + 8 * hh) = pk; }
    hy_build_taps(lds, hf + (size_t)1024 * 4096, tid);
    {   f32x16 acc;
#pragma unroll
        for (int r = 0; r < 16; ++r) acc[r] = 0.f;
        hy_conv_mfma(lds, i0, lane, acc);
        const int ch = 1024 + c; const float w0 = cw[ch], w1 = cw[3072 + ch], w2 = cw[2 * 3072 + ch], b0 = cb[ch];
        bf16_t* YB = (bf16_t*)(ws + WS_YB);
#pragma unroll
        for (int g = 0; g < 4; ++g) { const int t0 = 32 * blk + 8 * g + 4 * hh;
            float x2[4]; hy_cv4(PB + (size_t)ch * M + b * T, t0, w0, w1, w2, b0, x2);
#pragma unroll
            for (int q = 0; q < 4; ++q) YB[(size_t)(b * T + t0 + q) * 1024 + c] = (bf16_t)f2bf(x2[q] * (acc[4 * g + q] + bd1 * zf[4 * g + q])); }
    }
}

__device__ __forceinline__ float softplusf_(float x) { return fmaxf(x, 0.f) + log1pf(expf(-fabsf(x))); }
__device__ __forceinline__ float rw_mix(const bf16_t* PC, int tok, int x, float mp, float mn) {
    const int t = tok & (T - 1);
    const float c = bf2f(PC[(size_t)tok * CINP + x]);
    const float p = t > 0 ? bf2f(PC[(size_t)(tok - 1) * CINP + x]) : 0.f;
    const float n = t < T - 1 ? bf2f(PC[(size_t)(tok + 1) * CINP + x]) : 0.f;
    return c + mp * (p - c) + mn * (n - c);
}
__device__ __forceinline__ void rwkv_prep_unit(const PT& a, int l, int u, LAS unsigned char* lds) {
    unsigned char* ws = a.ws();
    const int tid = opaque_tid();
    const int tok0 = u * 8;
    const bf16_t* PC = (const bf16_t*)(ws + WS_PC);
    const float* mup = a.in(I_RW_MU_PREV) + (size_t)l * CIN; const float* mun = a.in(I_RW_MU_NEXT) + (size_t)l * CIN;
    LAS float* sg = (LAS float*)lds;
    LAS float* tw = sg + 8 * 128;
    LAS float* ad = tw + 8 * 96;
    LAS float* vv1 = ad + 8 * 96;
    LAS float* vmx = vv1 + 8 * 32;
    __syncthreads();
    for (int e = tid; e < 8 * 320; e += NTHREADS) { const int j = e / 320, xx = e - j * 320, x = 3072 + xx;
        const float c = rw_mix(PC, tok0 + j, x, mup[x], mun[x]);
        if (xx < 128) sg[j * 128 + xx] = sigmoidf_(c); else if (xx < 224) tw[j * 96 + (xx - 128)] = tanhf(c); else ad[j * 96 + (xx - 224)] = c; }
    if (l > 0) {
        for (int e = tid; e < 8 * 1024; e += NTHREADS) { const int j = e >> 10, ch = e & 1023; vmx[e] = rw_mix(PC, tok0 + j, 2048 + ch, mup[2048 + ch], mun[2048 + ch]); }
        __syncthreads();
        if (tid < 256) { const int j = tid >> 5, r = tid & 31; const float* v1 = a.in(I_RW_V1) + (size_t)(l - 1) * 1024 * VL; float acc = 0.f;
            for (int c = 0; c < 1024; ++c) acc += vmx[j * 1024 + c] * v1[c * VL + r];
            vv1[j * 32 + r] = acc; }
    }
    __syncthreads();
    float *Rb = (float*)(ws + WS_R), *Vb = (float*)(ws + WS_V), *Ab = (float*)(ws + WS_AA), *Wb = (float*)(ws + WS_WD), *Kb = (float*)(ws + WS_KD), *Bb = (float*)(ws + WS_BD),
          *Gb = (float*)(ws + WS_GG), *VF = (float*)(ws + WS_VFIRST);
#pragma unroll 1
    for (int half = 0; half < 2; ++half) {
        const int ch = tid + NTHREADS * half;
        float accw[2][8], acca[2][8], accg[8], accv[8];
#pragma unroll
        for (int j = 0; j < 8; ++j) { accw[0][j] = accw[1][j] = acca[0][j] = acca[1][j] = accg[j] = accv[j] = 0.f; }
        { const float* w2 = a.in(I_RW_W2) + (size_t)l * 2 * WL * 1024; const float* a2 = a.in(I_RW_A2) + (size_t)l * 2 * AL * 1024;
#pragma unroll
          for (int d = 0; d < 2; ++d)
            for (int r = 0; r < 48; ++r) { const float ww = w2[(size_t)(d * 48 + r) * 1024 + ch], wa = a2[(size_t)(d * 48 + r) * 1024 + ch];
#pragma unroll
                for (int j = 0; j < 8; ++j) { accw[d][j] += tw[j * 96 + d * 48 + r] * ww; acca[d][j] += ad[j * 96 + d * 48 + r] * wa; } } }
        { const float* g2 = a.in(I_RW_G2) + (size_t)l * GL * 1024;
          for (int r = 0; r < GL; ++r) { const float w = g2[(size_t)r * 1024 + ch];
#pragma unroll
              for (int j = 0; j < 8; ++j) accg[j] += sg[j * 128 + r] * w; } }
        if (l > 0) { const float* v2 = a.in(I_RW_V2) + (size_t)(l - 1) * VL * 1024;
          for (int r = 0; r < VL; ++r) { const float w = v2[(size_t)r * 1024 + ch];
#pragma unroll
              for (int j = 0; j < 8; ++j) accv[j] += vv1[j * 32 + r] * w; } }
        const float w00 = a.in(I_RW_W0)[(l * 2 + 0) * 1024 + ch], w01 = a.in(I_RW_W0)[(l * 2 + 1) * 1024 + ch];
        const float a00 = a.in(I_RW_A0)[(l * 2 + 0) * 1024 + ch], a01 = a.in(I_RW_A0)[(l * 2 + 1) * 1024 + ch];
        const float kkw = a.in(I_RW_K_K)[l * 1024 + ch], kaw = a.in(I_RW_K_A)[l * 1024 + ch];
        const float v0w = l > 0 ? a.in(I_RW_V0)[(l - 1) * 1024 + ch] : 0.f;
        const float mpr = mup[ch], mnr = mun[ch], mpk = mup[1024 + ch], mnk = mun[1024 + ch], mpv = mup[2048 + ch], mnv = mun[2048 + ch];
#pragma unroll
        for (int j = 0; j < 8; ++j) {
            const int tok = tok0 + j; const size_t o = (size_t)tok * 1024 + ch;
            const float r = rw_mix(PC, tok, ch, mpr, mnr), k = rw_mix(PC, tok, 1024 + ch, mpk, mnk);
            float v;
            if (l == 0) { v = rw_mix(PC, tok, 2048 + ch, mpv, mnv); VF[o] = v; }
            else { v = vmx[j * 1024 + ch]; v = v + (VF[o] - v) * sigmoidf_(v0w + accv[j]); }
            float kk = k * kkw; const float ss = wave_sum(kk * kk); kk = kk / fmaxf(sqrtf(ss), 1e-12f);
            Rb[o] = r; Vb[o] = v; Ab[o] = -kk; Gb[o] = accg[j];
#pragma unroll
            for (int d = 0; d < 2; ++d) {
                const float wl = -softplusf_(-((d ? w01 : w00) + accw[d][j])) - 0.5f;
                const float decay = expf(-expf(wl));
                const float aa = sigmoidf_((d ? a01 : a00) + acca[d][j]);
                const size_t od = (size_t)d * M * 1024 + o;
                Wb[od] = decay; Kb[od] = k * (1.f + (aa - 1.f) * kaw); Bb[od] = kk * aa;
            }
        }
    }
}

constexpr int ACT_PITCH = 848, VMX_PITCH = 2064, PREP_ACT_OFF = 0, PREP_VMX_OFF = 32 * ACT_PITCH, PREP_PART_OFF = PREP_VMX_OFF + 32 * VMX_PITCH;
__device__ __forceinline__ float red16d(float v) { v += dpp_mov<0xB1>(v); v += dpp_mov<0x4E>(v); v += dpp_mov<0x141>(v); v += dpp_mov<0x140>(v); return v; }
__device__ __forceinline__ void rw_mix4(const bf16_t* PC, int tok0, int x, float mp, float mn, float (&o)[4]) {
    const int t0 = tok0 & (T - 1); const bf16_t* p = PC + (size_t)tok0 * CINP + x;
    float c[6];
    c[0] = t0 > 0 ? bf2f(p[-(ptrdiff_t)CINP]) : 0.f;
#pragma unroll
    for (int q = 0; q < 4; ++q) c[1 + q] = bf2f(p[(size_t)q * CINP]);
    c[5] = t0 + 4 < T ? bf2f(p[(size_t)4 * CINP]) : 0.f;
#pragma unroll
    for (int q = 0; q < 4; ++q) o[q] = c[1 + q] + mp * (c[q] - c[1 + q]) + mn * (c[2 + q] - c[1 + q]);
}
__device__ __forceinline__ void rwkv_prep_unit2(const PT& a, int l, int u, LAS unsigned char* lds) {
    unsigned char* ws = a.ws();
    const int tid = opaque_tid(), lane = tid & 63, wave = __builtin_amdgcn_readfirstlane(tid >> 6);
    const int tokb = u * 32;
    const bf16_t* PC = (const bf16_t*)(ws + WS_PC);
    const float* mup = a.in(I_RW_MU_PREV) + (size_t)l * CIN; const float* mun = a.in(I_RW_MU_NEXT) + (size_t)l * CIN;
    __syncthreads();
    for (int e = tid; e < 32 * 4 * 16; e += NTHREADS) { const int j = e >> 6, seg = (e >> 4) & 3, r = 48 + (e & 15); *(LAS bf16_t*)(lds + PREP_ACT_OFF + j * ACT_PITCH + (seg * 64 + r) * 2) = 0; }
    for (int e = tid; e < 32 * 320; e += NTHREADS) { const int j = e / 320, xx = e - j * 320, x = 3072 + xx; const int tok = tokb + j, t = tok & (T - 1);
        const float c = bf2f(PC[(size_t)tok * CINP + x]); const float p = t > 0 ? bf2f(PC[(size_t)(tok - 1) * CINP + x]) : 0.f; const float n = t < T - 1 ? bf2f(PC[(size_t)(tok + 1) * CINP + x]) : 0.f;
        const float m = c + mup[x] * (p - c) + mun[x] * (n - c);
        int kk; float val;
        if (xx < 128) { kk = 256 + xx; val = sigmoidf_(m); }
        else if (xx < 224) { const int q = xx - 128, d = q >= 48; kk = d * 64 + (q - 48 * d); val = tanhf(m); }
        else { const int q = xx - 224, d = q >= 48; kk = 128 + d * 64 + (q - 48 * d); val = m; }
        *(LAS bf16_t*)(lds + PREP_ACT_OFF + j * ACT_PITCH + kk * 2) = (bf16_t)f2bf(val); }
    if (l > 0) {
        for (int e = tid; e < 32 * 128; e += NTHREADS) { const int j = e >> 7, c8 = (e & 127) * 8; const int tok = tokb + j, t = tok & (T - 1);
            const bf16_t* p = PC + (size_t)tok * CINP + 2048 + c8;
            const u32x4 cc = *(const u32x4*)p; u32x4 pp = {0u, 0u, 0u, 0u}, nn = {0u, 0u, 0u, 0u};
            if (t > 0) pp = *(const u32x4*)(p - CINP); if (t < T - 1) nn = *(const u32x4*)(p + CINP);
            float o[8];
#pragma unroll
            for (int q = 0; q < 4; ++q) { const float c0 = bflo(cc[q]), c1 = bfhi(cc[q]);
                o[2 * q] = c0 + mup[2048 + c8 + 2 * q] * (bflo(pp[q]) - c0) + mun[2048 + c8 + 2 * q] * (bflo(nn[q]) - c0);
                o[2 * q + 1] = c1 + mup[2048 + c8 + 2 * q + 1] * (bfhi(pp[q]) - c1) + mun[2048 + c8 + 2 * q + 1] * (bfhi(nn[q]) - c1); }
            u32x4 w; w.x = pk2(o[0], o[1]); w.y = pk2(o[2], o[3]); w.z = pk2(o[4], o[5]); w.w = pk2(o[6], o[7]);
            *(LAS u32x4*)(lds + PREP_VMX_OFF + j * VMX_PITCH + c8 * 2) = w; }
    }
    __syncthreads();
    const int l15 = lane & 15, lq = lane >> 4;
    if (l > 0) {
        const int tm = wave & 1, tn = (wave >> 1) & 1, kh = wave >> 2;
        const bf16_t* V1T = (const bf16_t*)(ws + WS_V1T) + (size_t)(l - 1) * 32 * 1024 + (size_t)(16 * tn + l15) * 1024 + kh * 512 + 8 * lq;
        const LAS unsigned char* ap = lds + PREP_VMX_OFF + (16 * tm + l15) * VMX_PITCH + (kh * 512 + 8 * lq) * 2;
        f32x4 acc = {0.f, 0.f, 0.f, 0.f};
#pragma unroll 4
        for (int ks = 0; ks < 16; ++ks) { const bf16x8 af = *(const LAS bf16x8*)(ap + ks * 64); const bf16x8 bfr = *(const bf16x8*)(V1T + ks * 32);
            acc = __builtin_amdgcn_mfma_f32_16x16x32_bf16(af, bfr, acc, 0, 0, 0); }
        *(LAS f32x4*)(lds + PREP_PART_OFF + wave * 1024 + lane * 16) = acc;
        __syncthreads();
        if (wave < 4) { const f32x4 p0 = *(const LAS f32x4*)(lds + PREP_PART_OFF + wave * 1024 + lane * 16), p1 = *(const LAS f32x4*)(lds + PREP_PART_OFF + (wave + 4) * 1024 + lane * 16);
#pragma unroll
            for (int r = 0; r < 4; ++r) *(LAS bf16_t*)(lds + PREP_ACT_OFF + (16 * tm + 4 * lq + r) * ACT_PITCH + (384 + 16 * tn + l15) * 2) = (bf16_t)f2bf(p0[r] + p1[r]); }
        __syncthreads();
    }
    float *Rb = (float*)(ws + WS_R), *Vb = (float*)(ws + WS_V), *Ab = (float*)(ws + WS_AA), *Wb = (float*)(ws + WS_WD), *Kb = (float*)(ws + WS_KD), *Bb = (float*)(ws + WS_BD),
          *Gb = (float*)(ws + WS_GG), *VF = (float*)(ws + WS_VFIRST);
    const bf16_t* WL = (const bf16_t*)(ws + WS_WLORA) + (size_t)l * 1024 * LORA_K;
#pragma unroll 1
    for (int hb = 0; hb < 4; ++hb) {
        const int head = 2 * wave + (hb >> 1), th = hb & 1;
        bf16x8 af[13];
        { const LAS unsigned char* ap = lds + PREP_ACT_OFF + (16 * th + l15) * ACT_PITCH + 16 * lq;
#pragma unroll
          for (int ks = 0; ks < 13; ++ks) af[ks] = *(const LAS bf16x8*)(ap + ks * 64); }
        f32x4 acc[4][6];
#pragma unroll
        for (int ct = 0; ct < 4; ++ct) {
            const bf16_t* wrow = WL + (size_t)(head * 64 + 16 * ct + l15) * LORA_K + 8 * lq;
#pragma unroll
            for (int kd = 0; kd < 6; ++kd) acc[ct][kd] = (f32x4){0.f, 0.f, 0.f, 0.f};
#pragma unroll
            for (int ks = 0; ks < 13; ++ks) { const int kd = ks < 8 ? (ks >> 1) : (ks < 12 ? 4 : 5);
                if (kd == 5 && l == 0) continue;
                const bf16x8 bfr = *(const bf16x8*)(wrow + ks * 32);
                acc[ct][kd] = __builtin_amdgcn_mfma_f32_16x16x32_bf16(af[ks], bfr, acc[ct][kd], 0, 0, 0); }
        }
        const int tok0 = tokb + 16 * th + 4 * lq;
        float kmix[4][4], ssq[4] = {0.f, 0.f, 0.f, 0.f};
#pragma unroll
        for (int ct = 0; ct < 4; ++ct) { const int ch = head * 64 + 16 * ct + l15; rw_mix4(PC, tok0, 1024 + ch, mup[1024 + ch], mun[1024 + ch], kmix[ct]);
            const float kkw = a.in(I_RW_K_K)[l * 1024 + ch];
#pragma unroll
            for (int r = 0; r < 4; ++r) { const float kk = kmix[ct][r] * kkw; ssq[r] += kk * kk; } }
        float rn[4];
#pragma unroll
        for (int r = 0; r < 4; ++r) rn[r] = 1.f / fmaxf(sqrtf(red16d(ssq[r])), 1e-12f);
#pragma unroll
        for (int ct = 0; ct < 4; ++ct) { const int ch = head * 64 + 16 * ct + l15;
            float rmix[4], vmix[4]; rw_mix4(PC, tok0, ch, mup[ch], mun[ch], rmix); rw_mix4(PC, tok0, 2048 + ch, mup[2048 + ch], mun[2048 + ch], vmix);
            const float w00 = a.in(I_RW_W0)[(l * 2 + 0) * 1024 + ch], w01 = a.in(I_RW_W0)[(l * 2 + 1) * 1024 + ch];
            const float a00 = a.in(I_RW_A0)[(l * 2 + 0) * 1024 + ch], a01 = a.in(I_RW_A0)[(l * 2 + 1) * 1024 + ch];
            const float kkw = a.in(I_RW_K_K)[l * 1024 + ch], kaw = a.in(I_RW_K_A)[l * 1024 + ch];
            const float v0w = l > 0 ? a.in(I_RW_V0)[(l - 1) * 1024 + ch] : 0.f;
#pragma unroll
            for (int r = 0; r < 4; ++r) { const size_t o = (size_t)(tok0 + r) * 1024 + ch;
                float v = vmix[r];
                if (l == 0) VF[o] = v; else v = v + (VF[o] - v) * sigmoidf_(v0w + acc[ct][5][r]);
                const float k = kmix[ct][r], kk = k * kkw * rn[r];
                Rb[o] = rmix[r]; Vb[o] = v; Ab[o] = -kk; Gb[o] = acc[ct][4][r];
#pragma unroll
                for (int d = 0; d < 2; ++d) {
                    const float wl = -softplusf_(-((d ? w01 : w00) + acc[ct][d][r])) - 0.5f;
                    const float decay = expf(-expf(wl));
                    const float aa = sigmoidf_((d ? a01 : a00) + acc[ct][2 + d][r]);
                    const size_t od = (size_t)d * M * 1024 + o;
                    Wb[od] = decay; Kb[od] = k * (1.f + (aa - 1.f) * kaw); Bb[od] = kk * aa; } }
        }
    }
}

struct ScanIn { f32x4 a0, a1, w0, w1, b0, b1, k0, k1, r0, r1; float v; };
__device__ __forceinline__ void scan_load(ScanIn& s, const float* Ab, const float* Wb, const float* Bb, const float* Kb, const float* Rb, const float* Vb, size_t base, int cg, int row) {
    const size_t o = base + cg * 8;
    s.a0 = *(const f32x4*)(Ab + o); s.a1 = *(const f32x4*)(Ab + o + 4); s.w0 = *(const f32x4*)(Wb + o); s.w1 = *(const f32x4*)(Wb + o + 4);
    s.b0 = *(const f32x4*)(Bb + o); s.b1 = *(const f32x4*)(Bb + o + 4); s.k0 = *(const f32x4*)(Kb + o); s.k1 = *(const f32x4*)(Kb + o + 4);
    s.r0 = *(const f32x4*)(Rb + o); s.r1 = *(const f32x4*)(Rb + o + 4); s.v = Vb[base + row];
}
__device__ __forceinline__ float red8(float v) { v += __shfl_xor(v, 1); v += __shfl_xor(v, 2); v += __shfl_xor(v, 4); return v; }
__device__ __forceinline__ void wkv_scan_seq(const PT& a, int seq) {
    unsigned char* ws = a.ws();
    const int tid = opaque_tid(), lane = tid & 63, wave = tid >> 6;
    const int dir = seq >> 6, b = (seq >> 4) & 3, h = seq & 15;
    const int cg = lane & 7, row = wave * 8 + (lane >> 3);
    const float *Rb = (const float*)(ws + WS_R), *Vb = (const float*)(ws + WS_V), *Ab = (const float*)(ws + WS_AA);
    const float *Wb = (const float*)(ws + WS_WD) + (size_t)dir * M * 1024, *Kb = (const float*)(ws + WS_KD) + (size_t)dir * M * 1024, *Bb = (const float*)(ws + WS_BD) + (size_t)dir * M * 1024;
    float* Y = (float*)(ws + WS_YS) + (size_t)dir * M * 1024;
    f32x4 S0 = {0.f, 0.f, 0.f, 0.f}, S1 = {0.f, 0.f, 0.f, 0.f};
    ScanIn cur, nxt;
    { const int tt = dir ? T - 1 : 0; scan_load(cur, Ab, Wb, Bb, Kb, Rb, Vb, (size_t)(b * T + tt) * 1024 + h * 64, cg, row); }
    for (int step = 0; step < T; ++step) {
        const int tt = dir ? T - 1 - step : step;
        const int sn = step + 1 < T ? step + 1 : step; const int tn = dir ? T - 1 - sn : sn;
        scan_load(nxt, Ab, Wb, Bb, Kb, Rb, Vb, (size_t)(b * T + tn) * 1024 + h * 64, cg, row);
        float sa = S0[0] * cur.a0[0] + S0[1] * cur.a0[1] + S0[2] * cur.a0[2] + S0[3] * cur.a0[3] + S1[0] * cur.a1[0] + S1[1] * cur.a1[1] + S1[2] * cur.a1[2] + S1[3] * cur.a1[3];
        sa = red8(sa);
        S0 = S0 * cur.w0 + sa * cur.b0 + cur.v * cur.k0;
        S1 = S1 * cur.w1 + sa * cur.b1 + cur.v * cur.k1;
        float y = S0[0] * cur.r0[0] + S0[1] * cur.r0[1] + S0[2] * cur.r0[2] + S0[3] * cur.r0[3] + S1[0] * cur.r1[0] + S1[1] * cur.r1[1] + S1[2] * cur.r1[2] + S1[3] * cur.r1[3];
        y = red8(y);
        if (cg == 0) Y[(size_t)(b * T + tt) * 1024 + h * 64 + row] = y;
        cur = nxt;
    }
}

constexpr int SC_TC = 32, SC_STEP_F = 384, SC_BUF_F = SC_TC * SC_STEP_F;
__device__ __forceinline__ float red8d(float v) { v += dpp_mov<0xB1>(v); v += dpp_mov<0x4E>(v); v += dpp_mov<0x141>(v); return v; }
__device__ __forceinline__ float dot8(const f32x4& s0, const f32x4& s1, const f32x4& x0, const f32x4& x1) {
    const f32x4 p = s0 * x0 + s1 * x1; return (p[0] + p[1]) + (p[2] + p[3]); }
__device__ __forceinline__ void scan_stage_chunk(LAS float* dst, int lt, int c, int dir, int b, int h, const float* pa, const float* pw, const float* pb, const float* pk, const float* pr, const float* pv) {
    f32x4 val[12];
#pragma unroll
    for (int i = 0; i < 12; ++i) { const int e = lt + 256 * i; const int step = e / 96, rem = e - 96 * step, vec = rem >> 4, q = rem & 15;
        const int gs = c * SC_TC + step; const int tt = dir ? T - 1 - gs : gs;
        const float* base = vec == 0 ? pa : (vec == 1 ? pw : (vec == 2 ? pb : (vec == 3 ? pk : (vec == 4 ? pr : pv))));
        val[i] = *(const f32x4*)(base + (size_t)(b * T + tt) * 1024 + h * 64 + q * 4); }
#pragma unroll
    for (int i = 0; i < 12; ++i) { const int e = lt + 256 * i; const int step = e / 96, rem = e - 96 * step;
        *(LAS f32x4*)(dst + step * SC_STEP_F + rem * 4) = val[i]; }
}
__device__ __forceinline__ void wkv_scan_seq2(const PT& a, int seq, LAS unsigned char* lds) {
    unsigned char* ws = a.ws();
    const int tid = opaque_tid(), lane = tid & 63, wave = __builtin_amdgcn_readfirstlane(tid >> 6);
    const int dir = seq >> 6, b = (seq >> 4) & 3, h = seq & 15;
    LAS float* buf = (LAS float*)lds;
    const float *pr = (const float*)(ws + WS_R), *pv = (const float*)(ws + WS_V), *pa = (const float*)(ws + WS_AA);
    const float *pw = (const float*)(ws + WS_WD) + (size_t)dir * M * 1024, *pk = (const float*)(ws + WS_KD) + (size_t)dir * M * 1024, *pb = (const float*)(ws + WS_BD) + (size_t)dir * M * 1024;
    float* Y = (float*)(ws + WS_YS) + (size_t)dir * M * 1024;
    const int cg = lane & 7, row0 = wave * 16 + 2 * (lane >> 3);
    f32x4 S00 = {0.f, 0.f, 0.f, 0.f}, S01 = S00, S10 = S00, S11 = S00;
    __syncthreads();
    if (wave >= 4) scan_stage_chunk(buf, tid - 256, 0, dir, b, h, pa, pw, pb, pk, pr, pv);
    __syncthreads();
#pragma unroll 1
    for (int c = 0; c < T / SC_TC; ++c) {
        if (wave >= 4) { if (c + 1 < T / SC_TC) scan_stage_chunk(buf + ((c + 1) & 1) * SC_BUF_F, tid - 256, c + 1, dir, b, h, pa, pw, pb, pk, pr, pv); }
        else {
            const LAS float* cb = buf + (c & 1) * SC_BUF_F + cg * 8;
            const LAS float* vb = buf + (c & 1) * SC_BUF_F + 320 + row0;
#pragma unroll 4
            for (int s = 0; s < SC_TC; ++s) {
                const LAS float* p = cb + s * SC_STEP_F;
                const f32x4 a0 = *(const LAS f32x4*)(p), a1 = *(const LAS f32x4*)(p + 4), w0 = *(const LAS f32x4*)(p + 64), w1 = *(const LAS f32x4*)(p + 68);
                const f32x4 b0 = *(const LAS f32x4*)(p + 128), b1 = *(const LAS f32x4*)(p + 132), k0 = *(const LAS f32x4*)(p + 192), k1 = *(const LAS f32x4*)(p + 196);
                const f32x4 r0 = *(const LAS f32x4*)(p + 256), r1 = *(const LAS f32x4*)(p + 260);
                const f32x2 vv = *(const LAS f32x2*)(vb + s * SC_STEP_F);
                const float sa0 = red8d(dot8(S00, S01, a0, a1)), sa1 = red8d(dot8(S10, S11, a0, a1));
                S00 = S00 * w0 + sa0 * b0 + vv[0] * k0; S01 = S01 * w1 + sa0 * b1 + vv[0] * k1;
                S10 = S10 * w0 + sa1 * b0 + vv[1] * k0; S11 = S11 * w1 + sa1 * b1 + vv[1] * k1;
                const float y0 = red8d(dot8(S00, S01, r0, r1)), y1 = red8d(dot8(S10, S11, r0, r1));
                const int gs = c * SC_TC + s; const int tt = dir ? T - 1 - gs : gs;
                if (cg == 0) *(f32x2*)(Y + (size_t)(b * T + tt) * 1024 + h * 64 + row0) = (f32x2){y0, y1};
            }
        }
        __syncthreads();
    }
}

__device__ __forceinline__ void rwkv_post_phase(const PT& a, int l) {
    unsigned char* ws = a.ws();
    const int tid = opaque_tid();
    const float *Rb = (const float*)(ws + WS_R), *Vb = (const float*)(ws + WS_V), *Kb = (const float*)(ws + WS_KD), *Gb = (const float*)(ws + WS_GG), *Y = (const float*)(ws + WS_YS);
    bf16_t* YC = (bf16_t*)(ws + WS_YC);
    for (int tok = blockIdx.x; tok < M; tok += gridDim.x) {
#pragma unroll
        for (int half = 0; half < 2; ++half) {
            const int ch = tid + NTHREADS * half; const size_t o = (size_t)tok * 1024 + ch;
            const float y = Y[o] + Y[(size_t)M * 1024 + o];
            const float mu = wave_sum(y) * (1.f / 64.f); const float d = y - mu; const float var = wave_sum(d * d) * (1.f / 64.f);
            const float yn = d * (1.f / sqrtf(var + GN_EPS)) * a.in(I_RW_LN_G)[l * 1024 + ch] + a.in(I_RW_LN_B)[l * 1024 + ch];
            const float r = Rb[o]; const float bon = wave_sum(r * (Kb[o] + Kb[(size_t)M * 1024 + o]) * a.in(I_RW_R_K)[l * 1024 + ch]);
            const float out = (yn + bon * Vb[o]) * Gb[o];
            YC[o] = (bf16_t)f2bf(out);
        }
    }
}

__device__ __forceinline__ void merge_phase(const PT& a) {
    unsigned char* ws = a.ws();
    const size_t gt = (size_t)blockIdx.x * NTHREADS + opaque_tid(), NGT = (size_t)gridDim.x * NTHREADS;
    const bf16_t* PG = (const bf16_t*)(ws + WS_PG); const bf16_t* PBR = (const bf16_t*)(ws + WS_PBR); bf16_t* MG = (bf16_t*)(ws + WS_MERGED);
    for (size_t i = gt; i < (size_t)M * D / 8; i += NGT) {
        const size_t m = i / (D / 8), c = (i % (D / 8)) * 8;
        float acc[8];
#pragma unroll
        for (int j = 0; j < 8; ++j) acc[j] = 0.f;
#pragma unroll
        for (int br = 0; br < 3; ++br) {
            const u32x4 g = *(const u32x4*)(PG + m * 6144 + br * 2048 + c); const u32x4 p = *(const u32x4*)(PBR + ((size_t)br * M + m) * D + c);
#pragma unroll
            for (int j = 0; j < 4; ++j) { acc[2 * j] += bflo(g[j]) * bflo(p[j]); acc[2 * j + 1] += bfhi(g[j]) * bfhi(p[j]); }
        }
        u32x4 o; o.x = pk2(acc[0], acc[1]); o.y = pk2(acc[2], acc[3]); o.z = pk2(acc[4], acc[5]); o.w = pk2(acc[6], acc[7]);
        *(u32x4*)(MG + m * D + c) = o;
    }
}

constexpr int PH_PRO_A = 0, PH_PRO_B = 1, PH_LAYER0 = 2, PH_PER_LAYER = 11, PH_FINAL = PH_LAYER0 + DEPTH * PH_PER_LAYER, N_PHASES = PH_FINAL + 1;

__global__ void __launch_bounds__(NTHREADS, 2) mk_fwd(Args args) {
    extern __shared__ __attribute__((aligned(16))) unsigned char lds_raw[];
    LAS unsigned char* lds = (LAS unsigned char*)lds_raw;
    const int tid = threadIdx.x;
    volatile LAS unsigned* misc = (volatile LAS unsigned*)(lds + LDS_MISC_OFF);
    if (tid < 64) misc[tid] = 0u;
    if (tid < 64) {   LAS unsigned long long* tab = (LAS unsigned long long*)(lds + PTAB_OFF);
        unsigned long long v = 0ull;
#pragma unroll
        for (int i = 0; i < N_INPUTS; ++i) v = (tid == i) ? (unsigned long long)args.in[i] : v;
        v = (tid == N_INPUTS) ? (unsigned long long)args.out : v;
        v = (tid == N_INPUTS + 1) ? (unsigned long long)args.ws : v;
        tab[tid] = v; }
    __syncthreads();
    const PT pt{lds};
    XcdBarrier bar = xcd_barrier_post((unsigned*)(pt.ws() + WS_CTL) + CW_BAR, misc + 8);
    const int lo = args.ph_lo, hi = args.ph_hi;
    const int G = gridDim.x, bid = blockIdx.x;
#define IN(k) (lo <= (k) && (k) < hi)
#define SEAM(k) do { if ((k) + 1 < hi) xcd_barrier(bar); } while (0)
#define REP(k) for (int rep_ = 0; rep_ < ((PROBE_DUP == (k)) ? 2 : 1); ++rep_)

    if (IN(PH_PRO_A)) { REP(100) { prologue_a(pt, lds); if (PROBE_DUP == 100) __syncthreads(); } SEAM(PH_PRO_A); }
    if (IN(PH_PRO_B)) { REP(101) prologue_b(pt, lds); SEAM(PH_PRO_B); }

#pragma unroll 1
    for (int l = 0; l < DEPTH; ++l) {
        const int p0 = PH_LAYER0 + l * PH_PER_LAYER;
        unsigned char* ws = pt.ws();
        float* X = (float*)(ws + WS_X); bf16_t* Hb = (bf16_t*)(ws + WS_H);
        if (IN(p0 + 0)) { REP(0) { rmsnorm_phase(X, pt.in(I_NORM_MIX_G) + l * D, Hb, nullptr); } SEAM(p0 + 0); }
        if (IN(p0 + 1)) { REP(1) {
            const bf16_t* W = (const bf16_t*)(ws + WS_WIN + l * WIN_L);
            pg8::SegOrder S{Hb, W, M / 256, NIN_MAIN / 256, W + (size_t)NIN_MAIN * D, Hb, 3 * BW / 256, M / 256, G, bid};
            pg8::EpiInProj E{(bf16_t*)(ws + WS_PA), (bf16_t*)(ws + WS_PC), (bf16_t*)(ws + WS_PG), (bf16_t*)(ws + WS_PB)};
            pg8::gemm_phase<pg8::EpiInProj>(lds, D, S, E);
            } SEAM(p0 + 1);
        }
        if (IN(p0 + 2)) { REP(2) {
            gmlp_stats_phase((const bf16_t*)(ws + WS_PA), (float*)(ws + WS_STATS));
            for (int u = bid; u < M / 32; u += G) rwkv_prep_unit2(pt, l, u, lds);
            } SEAM(p0 + 2);
        }
        if (IN(p0 + 3)) { REP(3) {
            if (G >= 256) {
                if (bid < 128) wkv_scan_seq2(pt, bid, lds);
                else { const int ob = bid - 128, on = G - 128;
                    for (int c = ob; c < BW; c += on) hyena_unit2(pt, l, c, lds);
                    for (int u = ob; u < 512; u += on) gmlp_unit(pt, l, u, lds); }
            } else {
                for (int s = bid; s < 128; s += G) wkv_scan_seq2(pt, s, lds);
                for (int c = bid; c < BW; c += G) hyena_unit2(pt, l, c, lds);
                for (int u = bid; u < 512; u += G) gmlp_unit(pt, l, u, lds);
            }
            } SEAM(p0 + 3);
        }
        if (IN(p0 + 4)) { REP(4) { rwkv_post_phase(pt, l); } SEAM(p0 + 4); }
        if (IN(p0 + 5)) { REP(5) {
            const bf16_t* W = (const bf16_t*)(ws + WS_WBR + l * WBR_L);
#pragma unroll 1
            for (int br = 0; br < 3; ++br) {
                const bf16_t* Y = (const bf16_t*)(ws + (br == 0 ? WS_YA : (br == 1 ? WS_YB : WS_YC)));
                pg8::SegOrder S{Y, W + (size_t)br * D * 1024, M / 256, D / 256, Y, W, 0, 0, G, bid};
                pg8::EpiBf16 E{(bf16_t*)(ws + WS_PBR) + (size_t)br * M * D, D, 0, 8};
                pg8::gemm_phase<pg8::EpiBf16>(lds, 1024, S, E);
            }
            } SEAM(p0 + 5);
        }
        if (IN(p0 + 6)) { REP(6) { merge_phase(pt); } SEAM(p0 + 6); }
        if (IN(p0 + 7)) { REP(7) {
            const bf16_t* Mg = (const bf16_t*)(ws + WS_MERGED); const bf16_t* W = (const bf16_t*)(ws + WS_WOUT + l * WOUT_L);
            pg8::SegOrder S{Mg, W, M / 256, D / 256, Mg, W, 0, 0, G, bid};
            pg8::EpiResidual E{X, D};
            pg8::gemm_phase<pg8::EpiResidual>(lds, D, S, E);
            } SEAM(p0 + 7);
        }
        if (IN(p0 + 8)) { REP(8) { rmsnorm_phase(X, pt.in(I_NORM_FFN_G) + l * D, Hb, nullptr); } SEAM(p0 + 8); }
        if (IN(p0 + 9)) { REP(9) {
            const bf16_t* W = (const bf16_t*)(ws + WS_WGU + l * WGU_L);
            pg8::SegOrder S{Hb, W, M / 256, 2 * DFF / 256, Hb, W, 0, 0, G, bid};
            pg8::EpiSwiGlu E{(bf16_t*)(ws + WS_ACT), DFF};
            pg8::gemm_phase<pg8::EpiSwiGlu>(lds, D, S, E);
            } SEAM(p0 + 9);
        }
        if (IN(p0 + 10)) { REP(10) {
            const bf16_t* Ac = (const bf16_t*)(ws + WS_ACT); const bf16_t* W = (const bf16_t*)(ws + WS_WDN + l * WDN_L);
            pg8::SegOrder S{Ac, W, M / 256, D / 256, Ac, W, 0, 0, G, bid};
            pg8::EpiResidual E{X, D};
            pg8::gemm_phase<pg8::EpiResidual>(lds, DFF, S, E);
            } SEAM(p0 + 10);
        }
    }
    if (IN(PH_FINAL)) rmsnorm_phase((const float*)(pt.ws() + WS_X), pt.in(I_NORM_FINAL_G), nullptr, pt.out());
#undef IN
#undef SEAM
}

extern "C" void kernel_launch(void* const* d_in, const int* in_sizes, int n_in, void* d_out, int out_size, void* d_ws, size_t ws_size, hipStream_t stream) {
    static int grid = 0;
    if (grid == 0) {
        if (n_in != N_INPUTS || out_size != M * D || ws_size < WS_END) { fprintf(stderr, "kernel_launch: unexpected shapes: n_in %d out %d ws %zu (need %zu)\n", n_in, out_size, ws_size, (size_t)WS_END); grid = -1; return; }
        int dev = 0, cus = 0, per_cu = 0;
        if (hipGetDevice(&dev) != hipSuccess || hipDeviceGetAttribute(&cus, hipDeviceAttributeMultiprocessorCount, dev) != hipSuccess) { grid = -1; return; }
        if (hipFuncSetAttribute((const void*)mk_fwd, hipFuncAttributeMaxDynamicSharedMemorySize, LDS_BYTES) != hipSuccess) { fprintf(stderr, "kernel_launch: hipFuncSetAttribute failed\n"); grid = -1; return; }
        if (hipOccupancyMaxActiveBlocksPerMultiprocessor(&per_cu, (const void*)mk_fwd, NTHREADS, LDS_BYTES) != hipSuccess || per_cu < 1) { fprintf(stderr, "kernel_launch: occupancy query says %d\n", per_cu); (void)hipGetLastError(); grid = -1; return; }
        grid = cus;
    }
    if (grid < 0) return;
    (void)hipMemsetAsync((char*)d_ws + WS_CTL, 0, CTL_ZERO_BYTES, stream);
    Args a{};
    for (int i = 0; i < N_INPUTS; ++i) a.in[i] = (const float*)d_in[i];
    a.out = (float*)d_out; a.ws = (unsigned char*)d_ws;
#if MK_LAUNCH_PER_PHASE
    for (int p = 0; p < N_PHASES; ++p) { a.ph_lo = p; a.ph_hi = p + 1; hipLaunchKernelGGL(mk_fwd, dim3(grid), dim3(NTHREADS), LDS_BYTES, stream, a); }
#else
    a.ph_lo = 0; a.ph_hi = N_PHASES;
    hipLaunchKernelGGL(mk_fwd, dim3(grid), dim3(NTHREADS), LDS_BYTES, stream, a);
#endif
}
```

```cpp
#include <hip/hip_runtime.h>
#include <cstdio>
#include <cstdint>

#ifndef PROBE_MASK
#define PROBE_MASK 0
#endif
#ifndef MK_LAUNCH_PER_PHASE
#define MK_LAUNCH_PER_PHASE 0
#endif

#define GAS __attribute__((address_space(1)))
#define LAS __attribute__((address_space(3)))
typedef unsigned short bf16_t;
typedef short bf16x8 __attribute__((ext_vector_type(8)));
typedef float f32x4 __attribute__((ext_vector_type(4)));
typedef float f32x2 __attribute__((ext_vector_type(2)));
typedef unsigned u32x4 __attribute__((ext_vector_type(4)));
typedef unsigned u32x2 __attribute__((ext_vector_type(2)));

constexpr int NB = 4, T = 2048, M = NB * T, D = 2048, DEPTH = 4;
constexpr int AW = 1024, AG = 8, CHUNK = 128;
constexpr int BW = 1024;
constexpr int CW = 1024, CH = 16, CN = 64, WL = 48, AL = 48, VL = 32, GL = 128;
constexpr int CIN = 3 * CW + GL + 2 * WL + 2 * AL;
constexpr int CINP = 3584;
constexpr int NIN = 2 * AW + 3 * BW + CIN + 3 * D;
constexpr int DFF = 5632;
constexpr int HYF = 64, HYE = 33;
constexpr float RMS_EPS = 1e-6f, LN_EPS = 1e-5f, GN_EPS = 64e-5f;
constexpr int NIN_MAIN = 2 * AW + CINP + 3 * D;
constexpr int NINP = NIN_MAIN + 3 * BW;

enum { I_X = 0, I_NORM_MIX_G, I_W_IN, I_GM_LN_G, I_GM_LN_B, I_GM_WS, I_GM_BS, I_HY_CONV_W, I_HY_CONV_B, I_HY_W1, I_HY_B1, I_HY_W2, I_HY_B2, I_HY_W3, I_HY_B3, I_HY_W4,
       I_HY_FREQ, I_HY_LOG_DECAY, I_HY_BIAS_D, I_RW_MU_PREV, I_RW_MU_NEXT, I_RW_W0, I_RW_W2, I_RW_A0, I_RW_A2, I_RW_V0, I_RW_V1, I_RW_V2, I_RW_G2, I_RW_K_K, I_RW_K_A,
       I_RW_R_K, I_RW_LN_G, I_RW_LN_B, I_W_BR_A, I_W_BR_B, I_W_BR_C, I_W_OUT, I_NORM_FFN_G, I_W_FFN_GATE, I_W_FFN_UP, I_W_FFN_DOWN, I_NORM_FINAL_G, N_INPUTS };

constexpr size_t MiB = 1u << 20;
constexpr size_t WS_CTL = 0, CTL_ZERO_BYTES = 1 * MiB;
constexpr size_t WS_WIN = 2 * MiB;
constexpr size_t WIN_L = (size_t)NINP * D * 2;
constexpr size_t WS_WBR = WS_WIN + 4 * WIN_L;
constexpr size_t WBR_L = (size_t)3 * D * 1024 * 2;
constexpr size_t WS_WOUT = WS_WBR + 4 * WBR_L;
constexpr size_t WOUT_L = (size_t)D * D * 2;
constexpr size_t WS_WGU = WS_WOUT + 4 * WOUT_L;
constexpr size_t WGU_L = (size_t)2 * DFF * D * 2;
constexpr size_t WS_WDN = WS_WGU + 4 * WGU_L;
constexpr size_t WDN_L = (size_t)D * DFF * 2;
constexpr size_t WS_HF = WS_WDN + 4 * WDN_L;
constexpr size_t HF_L = (size_t)2 * 1024 * 4096 * 4;
constexpr size_t WS_Z3 = WS_HF + 4 * HF_L;
constexpr size_t WS_X = WS_Z3 + 2 * MiB;
constexpr size_t WS_H = WS_X + (size_t)M * D * 4;
constexpr size_t WS_PA = WS_H + (size_t)M * D * 2;
constexpr size_t WS_PC = WS_PA + (size_t)M * 2048 * 2;
constexpr size_t WS_PG = WS_PC + (size_t)M * CINP * 2;
constexpr size_t WS_PB = WS_PG + (size_t)M * 6144 * 2;
constexpr size_t WS_STATS = WS_PB + (size_t)3072 * M * 2;
constexpr size_t WS_R = WS_STATS + 1 * MiB;
constexpr size_t ACT1K = (size_t)M * 1024 * 4;
constexpr size_t WS_V = WS_R + ACT1K;
constexpr size_t WS_AA = WS_V + ACT1K;
constexpr size_t WS_WD = WS_AA + ACT1K;
constexpr size_t WS_KD = WS_WD + 2 * ACT1K;
constexpr size_t WS_BD = WS_KD + 2 * ACT1K;
constexpr size_t WS_GG = WS_BD + 2 * ACT1K;
constexpr size_t WS_VFIRST = WS_GG + ACT1K;
constexpr size_t WS_YS = WS_VFIRST + ACT1K;
constexpr size_t WS_YA = WS_YS + 2 * ACT1K;
constexpr size_t WS_YB = WS_YA + (size_t)M * 1024 * 2;
constexpr size_t WS_YC = WS_YB + (size_t)M * 1024 * 2;
constexpr size_t WS_PBR = WS_YC + (size_t)M * 1024 * 2;
constexpr size_t WS_MERGED = WS_PBR + (size_t)3 * M * D * 2;
constexpr size_t WS_ACT = WS_MERGED + (size_t)M * D * 2;
constexpr size_t WS_WLORA = WS_ACT + (size_t)M * DFF * 2;
constexpr int LORA_K = 416;
constexpr size_t WLORA_L = (size_t)1024 * LORA_K * 2;
constexpr size_t WS_V1T = WS_WLORA + 4 * WLORA_L;
constexpr size_t WS_GWS = WS_V1T + 3 * (size_t)32 * 1024 * 2;
constexpr size_t WS_END = WS_GWS + (size_t)DEPTH * AG * 128 * 128 * 2;

constexpr int CW_BAR = 4096;

constexpr int LDS_BYTES = 147456;
constexpr int LDS_MISC_OFF = 145408;
constexpr int NTHREADS = 512, NWAVES = 8;

__device__ __forceinline__ unsigned f2bf(float f) { unsigned u = __builtin_bit_cast(unsigned, f); return (u + 0x7fffu + ((u >> 16) & 1u)) >> 16; }
__device__ __forceinline__ unsigned pk2(float lo, float hi) { return f2bf(lo) | (f2bf(hi) << 16); }
__device__ __forceinline__ float bf2f(unsigned h) { return __builtin_bit_cast(float, h << 16); }
__device__ __forceinline__ float bflo(unsigned w) { return __builtin_bit_cast(float, w << 16); }
__device__ __forceinline__ float bfhi(unsigned w) { return __builtin_bit_cast(float, w & 0xffff0000u); }
__device__ __forceinline__ float wave_sum(float v) {
#pragma unroll
    for (int o = 1; o < 64; o <<= 1) v += __shfl_xor(v, o);
    return v;
}
__device__ __forceinline__ int opaque_tid() { int t = threadIdx.x; asm volatile("" : "+v"(t)); return t; }
template <int CTRL> __device__ __forceinline__ float dpp_mov(float v) { return __builtin_bit_cast(float, __builtin_amdgcn_update_dpp(0, __builtin_bit_cast(int, v), CTRL, 0xf, 0xf, true)); }
__device__ __forceinline__ float sigmoidf_(float x) { return 1.f / (1.f + __expf(-x)); }
__device__ __forceinline__ float gelu_exact(float x) { return 0.5f * x * (1.f + erff(x * 0.70710678118654752f)); }

#define XB_TMO      128
#define XB_XCNT(j)  (256  + 64 * (j))
#define XB_XSUB(j)  (1280 + 64 * (j))
#define XB_XGEN(j)  (2304 + 64 * (j))
#define XB_TOP      3328
#define XB_TOPGEN   3392
#define XCD_BAR_WORDS 3456
#define XB_SPIN_CAP (1u << 18)

__device__ __forceinline__ unsigned xb_ld(unsigned* p)              { return __hip_atomic_load(p, __ATOMIC_RELAXED, __HIP_MEMORY_SCOPE_AGENT); }
__device__ __forceinline__ unsigned xb_add(unsigned* p, unsigned v) { return __hip_atomic_fetch_add(p, v, __ATOMIC_RELAXED, __HIP_MEMORY_SCOPE_AGENT); }
__device__ __forceinline__ unsigned xb_xcc_id() { return (unsigned)__builtin_amdgcn_s_getreg((3 << 11) | 20) & 0xFu; }
#define XB_SPIN(cond, bar) do { unsigned _sp = 0; while (cond) { __builtin_amdgcn_s_sleep(1); \
    if ((++_sp & 255u) == 0u) { if (xb_ld(&(bar)[XB_TMO])) break; if (_sp > XB_SPIN_CAP) { atomicAdd(&(bar)[XB_TMO], 1u); break; } } } } while (0)

struct XcdBarrier { unsigned* bar; unsigned x; volatile LAS unsigned* st; };

__device__ __forceinline__ XcdBarrier xcd_barrier_post(unsigned* bar, volatile LAS unsigned* st) {
    XcdBarrier b; b.bar = bar; b.x = xb_xcc_id(); b.st = st;
    if (threadIdx.x == 0) (void)xb_add(&bar[XB_XCNT(b.x)], 1u);
    return b;
}
__device__ __forceinline__ void xcd_barrier_complete(unsigned* bar, unsigned x, unsigned& nloc, unsigned& nx) {
    const unsigned G = gridDim.x * gridDim.y * gridDim.z;
    unsigned sum, cnt, mine, sp = 0u;
    for (;;) {
        sum = 0u; cnt = 0u; mine = 0u;
#pragma unroll
        for (unsigned j = 0; j < 16; ++j) { const unsigned c = xb_ld(&bar[XB_XCNT(j)]); sum += c; cnt += (c > 0u) ? 1u : 0u; mine = (j == x) ? c : mine; }
        if (sum == G) break;
        __builtin_amdgcn_s_sleep(1);
        if ((++sp & 255u) == 0u) { if (xb_ld(&bar[XB_TMO])) break; if (sp > XB_SPIN_CAP) { atomicAdd(&bar[XB_TMO], 1u); break; } }
    }
    nloc = mine > 0u ? mine : 1u; nx = cnt > 0u ? cnt : 1u;
}
__device__ __forceinline__ void xcd_barrier(const XcdBarrier& b) {
    asm volatile("s_waitcnt vmcnt(0)" ::: "memory");
    __syncthreads();
    if (threadIdx.x == 0) {
        unsigned* bar = b.bar;
        __builtin_amdgcn_s_waitcnt(0);
        unsigned nloc = b.st[0], nx = b.st[1];
        if (nloc == 0u) { xcd_barrier_complete(bar, b.x, nloc, nx); b.st[0] = nloc; b.st[1] = nx; }
        const unsigned old = xb_add(&bar[XB_XSUB(b.x)], 1u);
        const unsigned gen = old / nloc;
        if (old + 1u == (gen + 1u) * nloc) {
            __builtin_amdgcn_fence(__ATOMIC_RELEASE, "agent");
            asm volatile("s_waitcnt vmcnt(0)" ::: "memory");
            const unsigned og = xb_add(&bar[XB_TOP], 1u);
            const unsigned tg = og / nx;
            if (og + 1u == (tg + 1u) * nx) xb_add(&bar[XB_TOPGEN], 1u);
            else XB_SPIN(xb_ld(&bar[XB_TOPGEN]) == tg, bar);
            __builtin_amdgcn_fence(__ATOMIC_ACQUIRE, "agent");
            xb_add(&bar[XB_XGEN(b.x)], 1u);
            asm volatile("s_waitcnt vmcnt(0)" ::: "memory");
        } else {
            XB_SPIN(xb_ld(&bar[XB_XGEN(b.x)]) == gen, bar);
            __builtin_amdgcn_fence(__ATOMIC_ACQUIRE, "agent");
            asm volatile("s_waitcnt vmcnt(0)" ::: "memory");
        }
    }
    __syncthreads();
}

namespace pg8 {
constexpr int BM = 256, BK = 64, HALF = 128, HTB = HALF * BK * 2, STAGE_BYTES = 8 * HTB, NXCD = 8, WGM = 8;
__host__ __device__ __forceinline__ int lds_byte(int r, int c) { const int st = (r >> 4) * 2 + (c >> 5), rr = r & 15, cc = c & 31, ob = rr * 64 + cc * 2; return st * 1024 + (ob ^ (((ob >> 9) & 1) << 5)); }
__host__ __device__ __forceinline__ void stage_rc(int b, int& R, int& C) { const int st = b / 1024, sb = b % 1024, swz = sb ^ (((sb >> 9) & 1) << 5); R = (st >> 1) * 16 + swz / 64; C = (st & 1) * 32 + (swz % 64) / 2; }
__host__ __device__ __forceinline__ int perm32(int rho) { const int n = rho >> 4, i = rho & 15; return 8 * (i >> 2) + 4 * n + (i & 3); }

struct Unit { int pm, pn, seg; };
struct SegOrder {
    const bf16_t* A0; const bf16_t* B0; int nM0, nN0;
    const bf16_t* A1; const bf16_t* B1; int nM1, nN1;
    int G, c;
    __device__ __forceinline__ static void map(int L, int nM, int nN, int& pm, int& pn) {
        const int nwg = nM * nN; int wgid = L;
        { const int q = nwg / NXCD, r = nwg % NXCD, xcd = wgid % NXCD, off = wgid / NXCD; wgid = (xcd < r ? xcd * (q + 1) : r * (q + 1) + (xcd - r) * q) + off; }
        const int nig = WGM * nN, gid = wgid / nig, fm = gid * WGM, gsz = (nM - fm) < WGM ? (nM - fm) : WGM;
        pm = fm + ((wgid % nig) % gsz); pn = (wgid % nig) / gsz;
    }
    __device__ __forceinline__ bool next(int i, Unit& u) const {
        long L = (long)i * G + c; const int n0 = nM0 * nN0, n1 = nM1 * nN1;
        if (L < n0) { u.seg = 0; map((int)L, nM0, nN0, u.pm, u.pn); return true; }
        L -= n0;
        if (L < n1) { u.seg = 1; map((int)L, nM1, nN1, u.pm, u.pn); return true; }
        return false;
    }
    __device__ __forceinline__ const char* abase(const Unit& u) const { return (const char*)(u.seg ? A1 : A0); }
    __device__ __forceinline__ const char* bbase(const Unit& u) const { return (const char*)(u.seg ? B1 : B0); }
};

__device__ __forceinline__ unsigned cvt_pk_bf16(float lo, float hi) { unsigned r; asm volatile("v_cvt_pk_bf16_f32 %0, %1, %2" : "=v"(r) : "v"(lo), "v"(hi)); return r; }
__device__ __forceinline__ f32x2 gelu_pk(f32x2 v) {
    const f32x2 av = __builtin_elementwise_abs(v), d = av * 0.2316418882f + 1.0f;
    f32x2 t; t.x = __builtin_amdgcn_rcpf(d.x); t.y = __builtin_amdgcn_rcpf(d.y);
    f32x2 q = t * 0.5307027145f + (-0.7265760135f); q = q * t + 0.7107068705f; q = q * t + (-0.142248368f); q = q * t + 0.127414796f; q = q * t;
    const f32x2 s = (v * v) * (-0.72134752044f);
    f32x2 e; e.x = __builtin_amdgcn_exp2f(s.x); e.y = __builtin_amdgcn_exp2f(s.y);
    const f32x2 m = v * (q * e), r = v - m;
    f32x2 o; o.x = v.x < 0.f ? m.x : r.x; o.y = v.y < 0.f ? m.y : r.y; return o;
}
__device__ __forceinline__ float fast_sigmoid(float x) { return __builtin_amdgcn_rcpf(1.f + __builtin_amdgcn_exp2f(-1.4426950408889634f * x)); }

struct EpiInProj {
    bf16_t *PA, *PC, *PG, *PB;
    __device__ __forceinline__ void operator()(const f32x4 (&acc)[2][2][4][2], const Unit& u, int wr, int wc, int fr, int fq) const {
        const int row0 = u.pm * BM + wr * 64 + fr;
        int mode, ldc, colt; bf16_t* base;
        if (u.seg == 1) { mode = 0; ldc = M; colt = u.pn * BM; base = PB; }
        else if (u.pn < 8) { mode = 1; ldc = 2048; colt = u.pn * BM; base = PA; }
        else if (u.pn < 22) { mode = 0; ldc = CINP; colt = (u.pn - 8) * BM; base = PC; }
        else { mode = 2; ldc = 6144; colt = (u.pn - 22) * BM; base = PG; }
        const int col0 = colt + wc * 32 + 8 * fq;
#pragma unroll
        for (int ai = 0; ai < 2; ++ai)
#pragma unroll
            for (int m = 0; m < 4; ++m) { bf16_t* rowp = base + (size_t)(row0 + ai * HALF + m * 16) * ldc + col0;
#pragma unroll
                for (int bj = 0; bj < 2; ++bj) { f32x4 v0 = acc[ai][bj][m][0], v1 = acc[ai][bj][m][1];
                    if (mode == 1) { f32x2 a = gelu_pk((f32x2){v0[0], v0[1]}), b = gelu_pk((f32x2){v0[2], v0[3]}), c = gelu_pk((f32x2){v1[0], v1[1]}), d = gelu_pk((f32x2){v1[2], v1[3]});
                        v0 = (f32x4){a.x, a.y, b.x, b.y}; v1 = (f32x4){c.x, c.y, d.x, d.y}; }
                    else if (mode == 2) {
#pragma unroll
                        for (int j = 0; j < 4; ++j) { v0[j] = fast_sigmoid(v0[j]); v1[j] = fast_sigmoid(v1[j]); } }
                    u32x4 w; w.x = cvt_pk_bf16(v0[0], v0[1]); w.y = cvt_pk_bf16(v0[2], v0[3]); w.z = cvt_pk_bf16(v1[0], v1[1]); w.w = cvt_pk_bf16(v1[2], v1[3]);
                    *(u32x4*)(rowp + bj * HALF) = w; } }
    }
};
struct EpiBf16 {
    bf16_t* O; int ldc; size_t pn_stride; int pn_per;
    __device__ __forceinline__ void operator()(const f32x4 (&acc)[2][2][4][2], const Unit& u, int wr, int wc, int fr, int fq) const {
        const int row0 = u.pm * BM + wr * 64 + fr; const int tsel = u.pn / pn_per; const int col0 = (u.pn - tsel * pn_per) * BM + wc * 32 + 8 * fq;
        bf16_t* base = O + (size_t)tsel * pn_stride;
#pragma unroll
        for (int ai = 0; ai < 2; ++ai)
#pragma unroll
            for (int m = 0; m < 4; ++m) { bf16_t* rowp = base + (size_t)(row0 + ai * HALF + m * 16) * ldc + col0;
#pragma unroll
                for (int bj = 0; bj < 2; ++bj) { const f32x4 v0 = acc[ai][bj][m][0], v1 = acc[ai][bj][m][1];
                    u32x4 w; w.x = cvt_pk_bf16(v0[0], v0[1]); w.y = cvt_pk_bf16(v0[2], v0[3]); w.z = cvt_pk_bf16(v1[0], v1[1]); w.w = cvt_pk_bf16(v1[2], v1[3]);
                    *(u32x4*)(rowp + bj * HALF) = w; } }
    }
};
struct EpiSwiGlu {
    bf16_t* O; int ldc;
    __device__ __forceinline__ void operator()(const f32x4 (&acc)[2][2][4][2], const Unit& u, int wr, int wc, int fr, int fq) const {
        const int row0 = u.pm * BM + wr * 64 + fr; const int col0 = u.pn * HALF + wc * 32 + 8 * fq;
#pragma unroll
        for (int ai = 0; ai < 2; ++ai)
#pragma unroll
            for (int m = 0; m < 4; ++m) { bf16_t* rowp = O + (size_t)(row0 + ai * HALF + m * 16) * ldc + col0;
                f32x4 o0, o1;
#pragma unroll
                for (int j = 0; j < 4; ++j) { const float g0 = acc[ai][0][m][0][j], g1 = acc[ai][0][m][1][j];
                    o0[j] = g0 * fast_sigmoid(g0) * acc[ai][1][m][0][j]; o1[j] = g1 * fast_sigmoid(g1) * acc[ai][1][m][1][j]; }
                u32x4 w; w.x = cvt_pk_bf16(o0[0], o0[1]); w.y = cvt_pk_bf16(o0[2], o0[3]); w.z = cvt_pk_bf16(o1[0], o1[1]); w.w = cvt_pk_bf16(o1[2], o1[3]);
                *(u32x4*)rowp = w; }
    }
};
struct EpiResidual {
    float* X; int ldc;
    __device__ __forceinline__ void operator()(const f32x4 (&acc)[2][2][4][2], const Unit& u, int wr, int wc, int fr, int fq) const {
        const int row0 = u.pm * BM + wr * 64 + fr; const int col0 = u.pn * BM + wc * 32 + 8 * fq;
#pragma unroll
        for (int ai = 0; ai < 2; ++ai)
#pragma unroll
            for (int m = 0; m < 4; ++m) { float* rowp = X + (size_t)(row0 + ai * HALF + m * 16) * ldc + col0;
#pragma unroll
                for (int bj = 0; bj < 2; ++bj) { f32x4* p = (f32x4*)(rowp + bj * HALF); const f32x4 x0 = p[0], x1 = p[1];
                    p[0] = x0 + acc[ai][bj][m][0]; p[1] = x1 + acc[ai][bj][m][1]; } }
    }
};

template <class Epi>
__device__ __forceinline__ void gemm_phase(LAS unsigned char* lds, const int K, const SegOrder& S, const Epi& E) {
    int tid_ = threadIdx.x; asm volatile("" : "+v"(tid_));
    const int tid = tid_, wid = __builtin_amdgcn_readfirstlane(tid >> 6), lane = tid & 63, wr = wid >> 2, wc = wid & 3, fr = lane & 15, fq = lane >> 4;
    const int nt = K / BK;
    unsigned voffA[2], voffB[2];
#pragma unroll
    for (int i = 0; i < 2; ++i) { int R, C; stage_rc(tid * 16 + i * 8192, R, C); const int Rb = (R & ~31) + perm32(R & 31);
        voffA[i] = (unsigned)(R * K + C) * 2u; voffB[i] = (unsigned)(Rb * K + C) * 2u; }
    const size_t kstep = (size_t)(BK * 2);
    const size_t hstep = (size_t)HALF * K * 2;
    const size_t tstep = 2 * hstep;
    const unsigned ldsw = (unsigned)wid * 1024u;
    const int aoff = lds_byte(wr * 64 + fr, fq * 8), boff = lds_byte(wc * 32 + fr, fq * 8);
#define PG8_SA(b, h) (((b) * 2 + (h)) * HTB)
#define PG8_SB(b, h) ((4 + (b) * 2 + (h)) * HTB)
#define PG8_STAGE(bufoff, gbase, voff) do { _Pragma("unroll") for (int _i = 0; _i < 2; ++_i) \
        __builtin_amdgcn_global_load_lds((const unsigned*)((const char*)(gbase) + (voff)[_i]), (LAS unsigned*)(lds + (bufoff) + ldsw + _i * 8192), 16, 0, 0); } while (0)
#define PG8_LDA(dst, b, h) do { _Pragma("unroll") for (int m = 0; m < 4; ++m) _Pragma("unroll") for (int k = 0; k < 2; ++k) dst[m][k] = *(const LAS bf16x8*)(lds + PG8_SA(b, h) + aoff + m * 2048 + k * 1024); } while (0)
#define PG8_LDB(dst, b, h) do { _Pragma("unroll") for (int n = 0; n < 2; ++n) _Pragma("unroll") for (int k = 0; k < 2; ++k) dst[n][k] = *(const LAS bf16x8*)(lds + PG8_SB(b, h) + boff + n * 2048 + k * 1024); } while (0)
#define PG8_MMA(ai, bj, At, Bt) do { __builtin_amdgcn_s_setprio(1); _Pragma("unroll") for (int m = 0; m < 4; ++m) _Pragma("unroll") for (int n = 0; n < 2; ++n) _Pragma("unroll") for (int k = 0; k < 2; ++k) \
        acc[ai][bj][m][n] = __builtin_amdgcn_mfma_f32_16x16x32_bf16(Bt[n][k], At[m][k], acc[ai][bj][m][n], 0, 0, 0); __builtin_amdgcn_s_setprio(0); } while (0)
#define PG8_WAIT_V(n) asm volatile("s_waitcnt vmcnt(" #n ")" ::: "memory")
#define PG8_WAIT_L(n) asm volatile("s_waitcnt lgkmcnt(" #n ")" ::: "memory")
#define PG8_BAR __builtin_amdgcn_s_barrier()
#define PG8_SCHED __builtin_amdgcn_sched_barrier(0)
    Unit cur, nxt; int ui = 0;
    if (!S.next(0, cur)) return;
    f32x4 acc[2][2][4][2];
#pragma unroll
    for (int a = 0; a < 2; ++a)
#pragma unroll
        for (int b = 0; b < 2; ++b)
#pragma unroll
            for (int m = 0; m < 4; ++m)
#pragma unroll
                for (int n = 0; n < 2; ++n) acc[a][b][m][n] = (f32x4){0.f, 0.f, 0.f, 0.f};
    bf16x8 At[4][2], B0[2][2], B1[2][2];
    const char* cA = S.abase(cur) + (size_t)cur.pm * tstep; const char* cB = S.bbase(cur) + (size_t)cur.pn * tstep;
    PG8_STAGE(PG8_SB(0, 0), cB, voffB); PG8_STAGE(PG8_SB(0, 1), cB + hstep, voffB); PG8_STAGE(PG8_SA(0, 0), cA, voffA); PG8_STAGE(PG8_SA(0, 1), cA + hstep, voffA);
    if (wr == 1) PG8_BAR;
    PG8_WAIT_V(2); PG8_BAR;
    PG8_STAGE(PG8_SB(1, 0), cB + kstep, voffB); PG8_STAGE(PG8_SA(1, 0), cA + kstep, voffA); PG8_STAGE(PG8_SB(1, 1), cB + hstep + kstep, voffB);
    PG8_WAIT_V(6); PG8_BAR;
    for (;;) {
        const bool has_next = S.next(ui + 1, nxt);
        const char* nA = has_next ? S.abase(nxt) + (size_t)nxt.pm * tstep : cA; const char* nB = has_next ? S.bbase(nxt) + (size_t)nxt.pn * tstep : cB;
        for (int t = 0; t < nt; t += 2) {
            const bool last = (t == nt - 2);
            const char* a1 = cA + (size_t)(t + 1) * kstep;
            const char* a2 = last ? nA : cA + (size_t)(t + 2) * kstep; const char* b2 = last ? nB : cB + (size_t)(t + 2) * kstep;
            const char* a3 = a2 + kstep; const char* b3 = b2 + kstep;
            PG8_LDB(B0, 0, 0); PG8_LDB(B1, 0, 1); PG8_SCHED; PG8_LDA(At, 0, 0); PG8_STAGE(PG8_SA(1, 1), a1 + hstep, voffA);
            PG8_WAIT_V(8); PG8_WAIT_L(0); PG8_BAR; PG8_MMA(0, 0, At, B0); PG8_MMA(0, 1, At, B1); PG8_BAR; PG8_SCHED;
            PG8_LDA(At, 0, 1); PG8_STAGE(PG8_SB(0, 0), b2, voffB); PG8_STAGE(PG8_SB(0, 1), b2 + hstep, voffB); PG8_STAGE(PG8_SA(0, 0), a2, voffA);
            PG8_WAIT_V(8); PG8_WAIT_L(0); PG8_BAR; PG8_MMA(1, 0, At, B0); PG8_MMA(1, 1, At, B1); PG8_BAR; PG8_SCHED;
            PG8_LDB(B0, 1, 0); PG8_LDB(B1, 1, 1); PG8_SCHED; PG8_LDA(At, 1, 0); PG8_STAGE(PG8_SA(0, 1), a2 + hstep, voffA);
            PG8_WAIT_V(8); PG8_WAIT_L(0); PG8_BAR; PG8_MMA(0, 0, At, B0); PG8_MMA(0, 1, At, B1); PG8_BAR; PG8_SCHED;
            PG8_LDA(At, 1, 1); PG8_STAGE(PG8_SB(1, 0), b3, voffB); PG8_STAGE(PG8_SB(1, 1), b3 + hstep, voffB); PG8_STAGE(PG8_SA(1, 0), a3, voffA);
            PG8_WAIT_V(8); PG8_WAIT_L(0); PG8_BAR; PG8_MMA(1, 0, At, B0); PG8_MMA(1, 1, At, B1); PG8_BAR; PG8_SCHED;
        }
        if (wr == 0) PG8_BAR;
        E(acc, cur, wr, wc, fr, fq);
        if (!has_next) break;
#pragma unroll
        for (int a = 0; a < 2; ++a)
#pragma unroll
            for (int b = 0; b < 2; ++b)
#pragma unroll
                for (int m = 0; m < 4; ++m)
#pragma unroll
                    for (int n = 0; n < 2; ++n) acc[a][b][m][n] = (f32x4){0.f, 0.f, 0.f, 0.f};
        cur = nxt; cA = nA; cB = nB; ++ui;
        if (wr == 1) PG8_BAR;
    }
    PG8_WAIT_V(0);
    PG8_BAR;
#undef PG8_SA
#undef PG8_SB
#undef PG8_STAGE
#undef PG8_LDA
#undef PG8_LDB
#undef PG8_MMA
#undef PG8_WAIT_V
#undef PG8_WAIT_L
#undef PG8_BAR
#undef PG8_SCHED
}
}

struct Args { const float* in[N_INPUTS]; float* out; unsigned char* ws; int ph_lo, ph_hi; };
constexpr int PTAB_OFF = LDS_MISC_OFF + 256;
struct PT {
    LAS unsigned char* lds;
    __device__ __forceinline__ unsigned long long raw(int i) const { const u32x2 v = *(const LAS u32x2*)(lds + PTAB_OFF + 8 * i);
        return ((unsigned long long)(unsigned)__builtin_amdgcn_readfirstlane((int)v.y) << 32) | (unsigned long long)(unsigned)__builtin_amdgcn_readfirstlane((int)v.x); }
    __device__ __forceinline__ const float* in(int i) const { return (const float*)raw(i); }
    __device__ __forceinline__ float* out() const { return (float*)raw(N_INPUTS); }
    __device__ __forceinline__ unsigned char* ws() const { return (unsigned char*)raw(N_INPUTS + 1); }
};

__device__ __forceinline__ void transpose_item(const float* W, int Nsrc, int k0, int n0, bf16_t* WT, int Kd, int drow0, LAS float* scr, int lane) {
    f32x4 v[8];
    const int c4 = (lane & 7) * 4, kr = lane >> 3;
#pragma unroll
    for (int i = 0; i < 8; ++i) v[i] = *(const f32x4*)(W + (size_t)(k0 + kr + 8 * i) * Nsrc + n0 + c4);
#pragma unroll
    for (int i = 0; i < 8; ++i) { LAS float* s = scr + (kr + 8 * i) * 33 + c4; s[0] = v[i][0]; s[1] = v[i][1]; s[2] = v[i][2]; s[3] = v[i][3]; }
    asm volatile("s_waitcnt lgkmcnt(0)" ::: "memory");
    const int c = lane & 7;
#pragma unroll
    for (int j = 0; j < 4; ++j) { const int n = (lane >> 3) + 8 * j; const LAS float* s = scr + (8 * c) * 33 + n;
        u32x4 o; o.x = pk2(s[0 * 33], s[1 * 33]); o.y = pk2(s[2 * 33], s[3 * 33]); o.z = pk2(s[4 * 33], s[5 * 33]); o.w = pk2(s[6 * 33], s[7 * 33]);
        *(u32x4*)(WT + (size_t)(drow0 + n) * Kd + k0 + 8 * c) = o; }
    asm volatile("s_waitcnt lgkmcnt(0)" ::: "memory");
}

constexpr int IT_WIN = 32 * 458, IT_BR = 16 * 64, IT_OUT = 32 * 64, IT_GU = 32 * 176, IT_DN = 88 * 64;
constexpr int IT_LAYER = IT_WIN + 3 * IT_BR + IT_OUT + 2 * IT_GU + IT_DN;

__device__ __forceinline__ void convert_layer_weights(const PT& a, LAS unsigned char* lds, int l, int gw, int NGW, int wave, int lane) {
    unsigned char* ws = a.ws();
    LAS float* scr = (LAS float*)(lds + wave * 16384);
    for (int r0 = gw; r0 < IT_LAYER; r0 += NGW) {
        int r = r0;
        if (r < IT_WIN) { const int kb = r / 458, nb = r % 458, n0 = nb * 32;
            int drow; if (n0 < 2048) drow = n0; else if (n0 < 5120) drow = NIN_MAIN + (n0 - 2048); else if (n0 < 8512) drow = 2048 + (n0 - 5120); else drow = 5632 + (n0 - 8512);
            transpose_item(a.in(I_W_IN) + (size_t)l * D * NIN, NIN, kb * 64, n0, (bf16_t*)(ws + WS_WIN + l * WIN_L), D, drow, scr, lane); continue; }
        r -= IT_WIN;
        if (r < 3 * IT_BR) { const int br = r / IT_BR; r -= br * IT_BR; const int kb = r / 64, nb = r % 64;
            const float* src = a.in(br == 0 ? I_W_BR_A : (br == 1 ? I_W_BR_B : I_W_BR_C)) + (size_t)l * 1024 * D;
            transpose_item(src, D, kb * 64, nb * 32, (bf16_t*)(ws + WS_WBR + l * WBR_L) + (size_t)br * D * 1024, 1024, nb * 32, scr, lane); continue; }
        r -= 3 * IT_BR;
        if (r < IT_OUT) { const int kb = r / 64, nb = r % 64;
            transpose_item(a.in(I_W_OUT) + (size_t)l * D * D, D, kb * 64, nb * 32, (bf16_t*)(ws + WS_WOUT + l * WOUT_L), D, nb * 32, scr, lane); continue; }
        r -= IT_OUT;
        if (r < 2 * IT_GU) { const int up = r / IT_GU; r -= up * IT_GU; const int kb = r / 176, nb = r % 176, n0 = nb * 32;
            const float* src = a.in(up ? I_W_FFN_UP : I_W_FFN_GATE) + (size_t)l * D * DFF;
            transpose_item(src, DFF, kb * 64, n0, (bf16_t*)(ws + WS_WGU + l * WGU_L), D, 256 * (n0 / 128) + (n0 % 128) + 128 * up, scr, lane); continue; }
        r -= 2 * IT_GU;
        { const int kb = r / 64, nb = r % 64;
            transpose_item(a.in(I_W_FFN_DOWN) + (size_t)l * DFF * D, D, kb * 64, nb * 32, (bf16_t*)(ws + WS_WDN + l * WDN_L), DFF, nb * 32, scr, lane); }
    }
}

__device__ __forceinline__ void prologue_a(const PT& a, LAS unsigned char* lds) {
    unsigned char* ws = a.ws();
    const int tid = opaque_tid(), lane = tid & 63, wave = tid >> 6;
    const int gw = blockIdx.x * NWAVES + wave, NGW = gridDim.x * NWAVES;
    const size_t gt = (size_t)blockIdx.x * NTHREADS + tid, NGT = (size_t)gridDim.x * NTHREADS;
    { const f32x4* src = (const f32x4*)a.in(I_X); f32x4* dst = (f32x4*)(ws + WS_X);
      for (size_t i = gt; i < (size_t)M * D / 4; i += NGT) dst[i] = src[i]; }
    { for (int l = 0; l < DEPTH; ++l) { u32x4* p = (u32x4*)(ws + WS_WIN + l * WIN_L + (size_t)5440 * D * 2); const size_t n = (size_t)192 * D * 2 / 16;
        for (size_t i = gt; i < n; i += NGT) p[i] = (u32x4){0u, 0u, 0u, 0u}; } }
    convert_layer_weights(a, lds, 0, gw, NGW, wave, lane);
    { bf16_t* WL = (bf16_t*)(ws + WS_WLORA);
      for (size_t i = gt; i < (size_t)DEPTH * 1024 * LORA_K; i += NGT) { const int l = (int)(i / (1024 * LORA_K)); const int rem = (int)(i - (size_t)l * 1024 * LORA_K); const int ch = rem / LORA_K, k = rem - ch * LORA_K;
          float v = 0.f;
          if (k < 256) { const int seg = k >> 6, r = k & 63, d = seg & 1; if (r < 48) v = (seg < 2 ? a.in(I_RW_W2) : a.in(I_RW_A2))[(((size_t)l * 2 + d) * 48 + r) * 1024 + ch]; }
          else if (k < 384) v = a.in(I_RW_G2)[((size_t)l * GL + (k - 256)) * 1024 + ch];
          else if (l > 0) v = a.in(I_RW_V2)[((size_t)(l - 1) * VL + (k - 384)) * 1024 + ch];
          WL[i] = (bf16_t)f2bf(v); }
      { bf16_t* GW = (bf16_t*)(ws + WS_GWS); const float* gsrc = a.in(I_GM_WS); for (size_t i = gt; i < (size_t)DEPTH * AG * 128 * 128; i += NGT) GW[i] = (bf16_t)f2bf(gsrc[i]); }
      bf16_t* V1T = (bf16_t*)(ws + WS_V1T);
      for (size_t i = gt; i < (size_t)3 * 32 * 1024; i += NGT) { const int l1 = (int)(i >> 15), r = (int)(i >> 10) & 31, c = (int)(i & 1023);
          V1T[i] = (bf16_t)f2bf(a.in(I_RW_V1)[((size_t)l1 * 1024 + c) * VL + r]); } }
    for (int row = gw; row < DEPTH * T; row += NGW) {
        const int l = row / T, t = row % T, j = lane;
        float f = 0.f;
        if (lane == 0) f = (float)t / (float)(T - 1);
        else if (lane < HYE) { const int m = (lane - 1) & 15; const float fr = 1e-4f + (float)m * ((15.0f - 1e-4f) / 15.0f);
            const float ang = (6.283185307179586f / (float)T) * (float)t * fr; f = (lane <= 16) ? cosf(ang) : -sinf(ang); }
        const float fq = a.in(I_HY_FREQ)[l * HYF + j];
        float acc = a.in(I_HY_B1)[l * HYF + j];
        { const float* w = a.in(I_HY_W1) + (size_t)l * HYE * HYF;
          for (int i = 0; i < HYE; ++i) acc += __shfl(f, i) * w[i * HYF + j]; }
        float z = sinf(fq * acc);
        acc = a.in(I_HY_B2)[l * HYF + j];
        { const float* w = a.in(I_HY_W2) + (size_t)l * HYF * HYF;
          for (int i = 0; i < HYF; ++i) acc += __shfl(z, i) * w[i * HYF + j]; }
        z = sinf(fq * acc);
        acc = a.in(I_HY_B3)[l * HYF + j];
        { const float* w = a.in(I_HY_W3) + (size_t)l * HYF * HYF;
          for (int i = 0; i < HYF; ++i) acc += __shfl(z, i) * w[i * HYF + j]; }
        z = sinf(fq * acc);
        ((float*)(ws + WS_Z3))[(size_t)row * HYF + j] = z;
    }
}

__device__ __forceinline__ void prologue_b(const PT& a, LAS unsigned char* lds) {
    unsigned char* ws = a.ws();
    const int tid = opaque_tid(), lane = tid & 63, wave = tid >> 6;
    LAS float* w4s = (LAS float*)lds;
    LAS float* dec = w4s + 1024;
    LAS float* red = dec + 16;
    LAS float* inv = red + 128;
    for (int u = blockIdx.x; u < DEPTH * 2 * 128; u += gridDim.x) {
        const int l = u >> 8, o = (u >> 7) & 1, c0 = (u & 127) * 8;
        __syncthreads();
        for (int e = tid; e < 1024; e += NTHREADS) { const int j = e >> 4, q = e & 15, dir = q >> 3, cl = q & 7;
            w4s[q * 64 + j] = a.in(I_HY_W4)[((size_t)l * HYF + j) * 4096 + dir * 2048 + o * 1024 + c0 + cl]; }
        if (tid < 16) { const int dir = tid >> 3, cl = tid & 7; dec[tid] = expf(a.in(I_HY_LOG_DECAY)[(((size_t)l * 2 + dir) * 2 + o) * 1024 + c0 + cl]); }
        __syncthreads();
        float* hf = (float*)(ws + WS_HF) + (((size_t)l * 2 + o) * 1024 + c0) * 4096;
        if (tid < 128) red[tid] = 0.f;
        __syncthreads();
#pragma unroll 1
        for (int i = 0; i < 4; ++i) {
            const int t = tid + NTHREADS * i; const float tn = (float)t / (float)(T - 1);
            f32x4 z[16]; const f32x4* zp = (const f32x4*)((const float*)(ws + WS_Z3) + ((size_t)l * T + t) * HYF);
#pragma unroll
            for (int j = 0; j < 16; ++j) z[j] = zp[j];
#pragma unroll 1
            for (int q = 0; q < 16; ++q) { const int dir = q >> 3, cl = q & 7; const LAS f32x4* wq = (const LAS f32x4*)(w4s + q * 64);
                float acc = 0.f;
#pragma unroll
                for (int j = 0; j < 16; ++j) { const f32x4 w = wq[j]; acc += z[j][0] * w[0]; acc += z[j][1] * w[1]; acc += z[j][2] * w[2]; acc += z[j][3] * w[3]; }
                const float h = acc * expf(-tn * dec[q]);
                const float s = wave_sum(fabsf(h));
                if (lane == 0) red[wave * 16 + q] += s;
                if (dir == 0) hf[(size_t)cl * 4096 + 2048 + t] = h; else if (t >= 1) hf[(size_t)cl * 4096 + 2048 - t] = h; }
        }
        __syncthreads();
        if (tid < 8) { float s = 0.f; for (int w = 0; w < 8; ++w) s += red[w * 16 + tid] + red[w * 16 + 8 + tid]; inv[tid] = 1.f / s; }
        __syncthreads();
        for (int i = 0; i < 4; ++i) {
            const int t = tid + NTHREADS * i;
#pragma unroll
            for (int cl = 0; cl < 8; ++cl) { const float s = inv[cl];
                hf[(size_t)cl * 4096 + 2048 + t] *= s; if (t >= 1) hf[(size_t)cl * 4096 + 2048 - t] *= s; }
        }
        if (tid < 8) hf[(size_t)tid * 4096] = 0.f;
    }
}

__device__ __forceinline__ void rmsnorm_phase(const float* X, const float* g, bf16_t* Hb, float* Of) {
    const int tid = opaque_tid(), lane = tid & 63, wave = tid >> 6;
    const int gw = blockIdx.x * NWAVES + wave, NGW = gridDim.x * NWAVES;
    for (int m = gw; m < M; m += NGW) {
        const f32x4* xr = (const f32x4*)(X + (size_t)m * D) + lane;
        f32x4 v[8]; float s = 0.f;
#pragma unroll
        for (int j = 0; j < 8; ++j) { v[j] = xr[64 * j]; s += (v[j][0] * v[j][0] + v[j][1] * v[j][1]) + (v[j][2] * v[j][2] + v[j][3] * v[j][3]); }
        const float rstd = 1.f / sqrtf(wave_sum(s) * (1.f / D) + RMS_EPS);
#pragma unroll
        for (int j = 0; j < 8; ++j) { const f32x4 gv = ((const f32x4*)g)[lane + 64 * j]; const f32x4 y = v[j] * rstd * gv;
            if (Of) ((f32x4*)(Of + (size_t)m * D))[lane + 64 * j] = y;
            else { u32x2 o; o.x = pk2(y[0], y[1]); o.y = pk2(y[2], y[3]); ((u32x2*)(Hb + (size_t)m * D))[lane + 64 * j] = o; } }
    }
}

__device__ __forceinline__ void gmlp_stats_phase(const bf16_t* PA, float* stats) {
    const int tid = opaque_tid(), lane = tid & 63, wave = tid >> 6;
    const int gw = blockIdx.x * NWAVES + wave, NGW = gridDim.x * NWAVES;
    for (int m = gw; m < M; m += NGW) {
        const u32x4* p = (const u32x4*)(PA + (size_t)m * 2048 + 1024) + lane * 2;
        const u32x4 a = p[0], b = p[1];
        float v[16];
#pragma unroll
        for (int j = 0; j < 4; ++j) { v[2 * j] = bflo(a[j]); v[2 * j + 1] = bfhi(a[j]); v[8 + 2 * j] = bflo(b[j]); v[8 + 2 * j + 1] = bfhi(b[j]); }
        float s = 0.f;
#pragma unroll
        for (int j = 0; j < 16; ++j) s += v[j];
        const float mu = wave_sum(s) * (1.f / 1024.f); float s2 = 0.f;
#pragma unroll
        for (int j = 0; j < 16; ++j) { const float d = v[j] - mu; s2 += d * d; }
        const float rstd = 1.f / sqrtf(wave_sum(s2) * (1.f / 1024.f) + LN_EPS);
        if (lane == 0) { stats[2 * m] = mu; stats[2 * m + 1] = rstd; }
    }
}

__device__ __forceinline__ void gmlp_unit(const PT& a, int l, int u, LAS unsigned char* lds) {
    unsigned char* ws = a.ws();
    const int tid = opaque_tid();
    const int g = u & 7, ck = u >> 3;
    const int tok0 = ck * CHUNK;
    LAS float* vn = (LAS float*)lds;
    LAS float* wsT = vn + 128 * 128;
    const bf16_t* PA = (const bf16_t*)(ws + WS_PA); const float* stats = (const float*)(ws + WS_STATS);
    const float* lng = a.in(I_GM_LN_G) + l * AW + g * 128; const float* lnb = a.in(I_GM_LN_B) + l * AW + g * 128;
    __syncthreads();
    for (int e = tid; e < 128 * 128; e += NTHREADS) { const int q = e >> 7, d = e & 127;
        const float x = bf2f(PA[(size_t)(tok0 + q) * 2048 + 1024 + g * 128 + d]);
        vn[e] = (x - stats[2 * (tok0 + q)]) * stats[2 * (tok0 + q) + 1] * lng[d] + lnb[d]; }
    { const float* wsrc = a.in(I_GM_WS) + ((size_t)l * AG + g) * 128 * 128;
      for (int e = tid; e < 128 * 128; e += NTHREADS) { const int p = e >> 7, q = e & 127; wsT[q * 128 + p] = wsrc[e]; } }
    __syncthreads();
    const int dg = tid & 31, pg = tid >> 5;
    float acc[8][4];
#pragma unroll
    for (int i = 0; i < 8; ++i)
#pragma unroll
        for (int j = 0; j < 4; ++j) acc[i][j] = 0.f;
    for (int q = 0; q < 128; ++q) {
        const f32x4 vv = *(const LAS f32x4*)(vn + q * 128 + 4 * dg);
        const f32x4 w0 = *(const LAS f32x4*)(wsT + q * 128 + 8 * pg), w1 = *(const LAS f32x4*)(wsT + q * 128 + 8 * pg + 4);
#pragma unroll
        for (int j = 0; j < 4; ++j) {
#pragma unroll
            for (int i = 0; i < 4; ++i) { acc[i][j] += w0[i] * vv[j]; acc[4 + i][j] += w1[i] * vv[j]; } }
    }
    const float* bs = a.in(I_GM_BS) + ((size_t)l * AG + g) * 128;
    bf16_t* YA = (bf16_t*)(ws + WS_YA);
#pragma unroll
    for (int i = 0; i < 8; ++i) { const int p = 8 * pg + i; const float bb = bs[p];
        const u32x2 uu = *(const u32x2*)(PA + (size_t)(tok0 + p) * 2048 + g * 128 + 4 * dg);
        const float y0 = bflo(uu.x) * (acc[i][0] + bb), y1 = bfhi(uu.x) * (acc[i][1] + bb), y2 = bflo(uu.y) * (acc[i][2] + bb), y3 = bfhi(uu.y) * (acc[i][3] + bb);
        u32x2 o; o.x = pk2(y0, y1); o.y = pk2(y2, y3);
        *(u32x2*)(YA + (size_t)(tok0 + p) * 1024 + g * 128 + 4 * dg) = o; }
}

typedef float f32x16 __attribute__((ext_vector_type(16)));
constexpr int GM_PITCH = 272;
__device__ __forceinline__ void gmlp_unit2(const PT& a, int l, int u, LAS unsigned char* lds) {
    unsigned char* ws = a.ws();
    const int tid = opaque_tid(), lane = tid & 63, wave = __builtin_amdgcn_readfirstlane(tid >> 6);
    const int g = u & 7, ck = u >> 3, tok0 = ck * CHUNK;
    const bf16_t* PA = (const bf16_t*)(ws + WS_PA); const float* stats = (const float*)(ws + WS_STATS);
    const float* lng = a.in(I_GM_LN_G) + l * AW + g * 128; const float* lnb = a.in(I_GM_LN_B) + l * AW + g * 128;
    __syncthreads();
    for (int e = tid; e < 128 * 32; e += NTHREADS) { const int q = e >> 5, d4 = (e & 31) * 4;
        const u32x2 x = *(const u32x2*)(PA + (size_t)(tok0 + q) * 2048 + 1024 + g * 128 + d4);
        const float mu = stats[2 * (tok0 + q)], rs = stats[2 * (tok0 + q) + 1];
        const f32x4 gg = *(const f32x4*)(lng + d4), bb = *(const f32x4*)(lnb + d4);
        const float v0 = (bflo(x.x) - mu) * rs * gg[0] + bb[0], v1 = (bfhi(x.x) - mu) * rs * gg[1] + bb[1], v2 = (bflo(x.y) - mu) * rs * gg[2] + bb[2], v3 = (bfhi(x.y) - mu) * rs * gg[3] + bb[3];
        LAS unsigned char* p = lds + d4 * GM_PITCH + q * 2;
        *(LAS bf16_t*)(p) = (bf16_t)f2bf(v0); *(LAS bf16_t*)(p + GM_PITCH) = (bf16_t)f2bf(v1); *(LAS bf16_t*)(p + 2 * GM_PITCH) = (bf16_t)f2bf(v2); *(LAS bf16_t*)(p + 3 * GM_PITCH) = (bf16_t)f2bf(v3); }
    __syncthreads();
    const int pt_ = wave & 3, dt0 = (wave >> 2) * 2, n = lane & 31, hh = lane >> 5;
    const bf16_t* wrow = (const bf16_t*)(ws + WS_GWS) + (((size_t)l * AG + g) * 128 + pt_ * 32 + n) * 128 + 8 * hh;
    f32x16 acc0, acc1;
#pragma unroll
    for (int r = 0; r < 16; ++r) { acc0[r] = 0.f; acc1[r] = 0.f; }
    const LAS unsigned char* b0p = lds + (dt0 * 32 + n) * GM_PITCH + 16 * hh;
#pragma unroll
    for (int ks = 0; ks < 8; ++ks) { const bf16x8 af = *(const bf16x8*)(wrow + ks * 16);
        const bf16x8 bf0 = *(const LAS bf16x8*)(b0p + ks * 32), bf1 = *(const LAS bf16x8*)(b0p + 32 * GM_PITCH + ks * 32);
        acc0 = __builtin_amdgcn_mfma_f32_32x32x16_bf16(af, bf0, acc0, 0, 0, 0);
        acc1 = __builtin_amdgcn_mfma_f32_32x32x16_bf16(af, bf1, acc1, 0, 0, 0); }
    const float* bs = a.in(I_GM_BS) + ((size_t)l * AG + g) * 128;
    bf16_t* YA = (bf16_t*)(ws + WS_YA);
#pragma unroll
    for (int r = 0; r < 16; ++r) { const int p = pt_ * 32 + (r & 3) + 8 * (r >> 2) + 4 * hh; const float bb = bs[p];
        const size_t o = (size_t)(tok0 + p) * 2048 + g * 128 + dt0 * 32 + n;
        const float u0 = bf2f(PA[o]), u1 = bf2f(PA[o + 32]);
        const size_t oy = (size_t)(tok0 + p) * 1024 + g * 128 + dt0 * 32 + n;
        YA[oy] = (bf16_t)f2bf(u0 * (acc0[r] + bb)); YA[oy + 32] = (bf16_t)f2bf(u1 * (acc1[r] + bb)); }
}

__device__ __forceinline__ float hy_cv(const bf16_t* row, int t, float w0, float w1, float w2, float cb) {
    const float c = bf2f(row[t]); const float p = t > 0 ? bf2f(row[t - 1]) : 0.f; const float n = t < T - 1 ? bf2f(row[t + 1]) : 0.f;
    return w0 * p + w1 * c + w2 * n + cb;
}
__device__ __forceinline__ void hyena_unit(const PT& a, int l, int c, LAS unsigned char* lds) {
    unsigned char* ws = a.ws();
    const int tid = opaque_tid();
    LAS float* taps = (LAS float*)lds;
    LAS float* zin = taps + 4096;
    const bf16_t* PB = (const bf16_t*)(ws + WS_PB);
    const float* cw = a.in(I_HY_CONV_W) + (size_t)l * 3 * 3072; const float* cb = a.in(I_HY_CONV_B) + (size_t)l * 3072;
    const float* hf = (const float*)(ws + WS_HF) + (((size_t)l * 2 + 0) * 1024 + c) * 4096;
    const float bd0 = a.in(I_HY_BIAS_D)[(l * 2 + 0) * 1024 + c], bd1 = a.in(I_HY_BIAS_D)[(l * 2 + 1) * 1024 + c];
    __syncthreads();
    for (int e = tid; e < 4096; e += NTHREADS) taps[e] = hf[e];
    { const int ch = 2048 + c; const float w0 = cw[ch], w1 = cw[3072 + ch], w2 = cw[2 * 3072 + ch], b0 = cb[ch];
      for (int e = tid; e < T * 4; e += NTHREADS) { const int b = e >> 11, t = e & (T - 1); zin[t * 4 + b] = hy_cv(PB + (size_t)ch * M + b * T, t, w0, w1, w2, b0); } }
    __syncthreads();
    float acc[4][4];
#pragma unroll
    for (int order = 0; order < 2; ++order) {
#pragma unroll
        for (int i = 0; i < 4; ++i)
#pragma unroll
            for (int b = 0; b < 4; ++b) acc[i][b] = 0.f;
        for (int s = 0; s < T; ++s) {
            const f32x4 zv = *(const LAS f32x4*)(zin + s * 4);
#pragma unroll
            for (int i = 0; i < 4; ++i) { const float k = taps[tid + NTHREADS * i - s + 2048];
#pragma unroll
                for (int b = 0; b < 4; ++b) acc[i][b] += k * zv[b]; }
        }
        const float bd = order == 0 ? bd0 : bd1;
#pragma unroll
        for (int i = 0; i < 4; ++i) { const f32x4 zv = *(const LAS f32x4*)(zin + (tid + NTHREADS * i) * 4);
#pragma unroll
            for (int b = 0; b < 4; ++b) acc[i][b] += bd * zv[b]; }
        __syncthreads();
        const int ch = order == 0 ? c : 1024 + c;
        const float w0 = cw[ch], w1 = cw[3072 + ch], w2 = cw[2 * 3072 + ch], b0 = cb[ch];
        if (order == 0) {
#pragma unroll
            for (int i = 0; i < 4; ++i) { const int t = tid + NTHREADS * i; f32x4 o;
#pragma unroll
                for (int b = 0; b < 4; ++b) o[b] = acc[i][b] * hy_cv(PB + (size_t)ch * M + b * T, t, w0, w1, w2, b0);
                *(LAS f32x4*)(zin + t * 4) = o; }
            for (int e = tid; e < 4096; e += NTHREADS) taps[e] = hf[(size_t)1024 * 4096 + e];
            __syncthreads();
        } else {
            bf16_t* YB = (bf16_t*)(ws + WS_YB);
#pragma unroll
            for (int i = 0; i < 4; ++i) { const int t = tid + NTHREADS * i;
#pragma unroll
                for (int b = 0; b < 4; ++b) YB[(size_t)(b * T + t) * 1024 + c] = (bf16_t)f2bf(acc[i][b] * hy_cv(PB + (size_t)ch * M + b * T, t, w0, w1, w2, b0)); }
        }
    }
}

constexpr int HYK_OFF = 0, HYZ_OFF = 65536, HYZ_PITCH = 320, HYT_OFF = HYZ_OFF + 25088;
__device__ __forceinline__ void hy_cv4(const bf16_t* row, int t0, float w0, float w1, float w2, float cb, float (&o)[4]) {
    const u32x2 x = *(const u32x2*)(row + t0);
    const float xm = t0 > 0 ? bf2f(row[t0 - 1]) : 0.f, xp = t0 + 4 < T ? bf2f(row[t0 + 4]) : 0.f;
    const float x0 = bflo(x.x), x1 = bfhi(x.x), x2 = bflo(x.y), x3 = bfhi(x.y);
    o[0] = w0 * xm + w1 * x0 + w2 * x1 + cb; o[1] = w0 * x0 + w1 * x1 + w2 * x2 + cb; o[2] = w0 * x1 + w1 * x2 + w2 * x3 + cb; o[3] = w0 * x2 + w1 * x3 + w2 * xp + cb;
}
__device__ __forceinline__ void hy_build_taps(LAS unsigned char* lds, const float* hf, int tid) {
    LAS float* tapf = (LAS float*)(lds + HYT_OFF);
    for (int e = tid; e < 1024; e += NTHREADS) *(LAS f32x4*)(tapf + 4 * e) = *(const f32x4*)(hf + 4 * e);
    __syncthreads();
#pragma unroll
    for (int i = 0; i < 8; ++i) { const int uid = tid + NTHREADS * i, yq = uid >> 3, sg = uid & 7; const int i0 = 4096 - 8 * yq + sg;
        float v[8];
#pragma unroll
        for (int e = 0; e < 8; ++e) { const int idx = i0 - e; v[e] = idx < 4096 ? tapf[idx] : 0.f; }
        u32x4 o; o.x = pk2(v[0], v[1]); o.y = pk2(v[2], v[3]); o.z = pk2(v[4], v[5]); o.w = pk2(v[6], v[7]);
        *(LAS u32x4*)(lds + HYK_OFF + uid * 16) = o; }
    __syncthreads();
}
__device__ __forceinline__ void hy_conv_mfma(LAS unsigned char* lds, int i0, int lane, f32x16& acc) {
    const int j = lane & 31, hh = lane >> 5, jq = j >> 3, jr = j & 7, bl = j >> 2, b = j & 3;
    const int dmin = i0 - 63;
    const LAS unsigned char* ap = lds + HYK_OFF + (256 - 4 * dmin - jq + hh) * 128 + jr * 16;
    const LAS unsigned char* bp = lds + HYZ_OFF + (i0 + bl - dmin + 7) * HYZ_PITCH + hh * 64 + b * 16;
#pragma unroll 2
    for (int d = 0; d < 71; ++d) {
        const bf16x8 a0 = *(const LAS bf16x8*)(ap), a1 = *(const LAS bf16x8*)(ap + 256);
        const bf16x8 b0 = *(const LAS bf16x8*)(bp), b1 = *(const LAS bf16x8*)(bp + 128);
        acc = __builtin_amdgcn_mfma_f32_32x32x16_bf16(a0, b0, acc, 0, 0, 0);
        acc = __builtin_amdgcn_mfma_f32_32x32x16_bf16(a1, b1, acc, 0, 0, 0);
        ap -= 512; bp -= HYZ_PITCH;
    }
}
__device__ __forceinline__ void hyena_unit2(const PT& a, int l, int c, LAS unsigned char* lds) {
    unsigned char* ws = a.ws();
    const int tid = opaque_tid(), lane = tid & 63, wave = __builtin_amdgcn_readfirstlane(tid >> 6);
    const bf16_t* PB = (const bf16_t*)(ws + WS_PB);
    const float* cw = a.in(I_HY_CONV_W) + (size_t)l * 3 * 3072; const float* cb = a.in(I_HY_CONV_B) + (size_t)l * 3072;
    const float* hf = (const float*)(ws + WS_HF) + (((size_t)l * 2 + 0) * 1024 + c) * 4096;
    const float bd0 = a.in(I_HY_BIAS_D)[(l * 2 + 0) * 1024 + c], bd1 = a.in(I_HY_BIAS_D)[(l * 2 + 1) * 1024 + c];
    __syncthreads();
    { const int ch = 2048 + c; const float w0 = cw[ch], w1 = cw[3072 + ch], w2 = cw[2 * 3072 + ch], b0 = cb[ch];
      for (int e = tid; e < 2 * 7 * HYZ_PITCH / 4; e += NTHREADS) { const int off = e * 4; ((LAS unsigned*)(lds + HYZ_OFF + (off < 7 * HYZ_PITCH ? off : off + 64 * HYZ_PITCH)))[0] = 0u; }
#pragma unroll
      for (int i = 0; i < 4; ++i) { const int e = tid + NTHREADS * i, b = e >> 9, t0 = (e & 511) * 4; float o[4];
          hy_cv4(PB + (size_t)ch * M + b * T, t0, w0, w1, w2, b0, o);
          u32x2 pk; pk.x = pk2(o[0], o[1]); pk.y = pk2(o[2], o[3]);
          *(LAS u32x2*)(lds + HYZ_OFF + ((t0 >> 5) + 7) * HYZ_PITCH + ((t0 >> 3) & 3) * 64 + b * 16 + (t0 & 7) * 2) = pk; } }
    hy_build_taps(lds, hf, tid);
    const int i0 = wave * 8, n = lane & 31, hh = lane >> 5, bl = n >> 2, b = n & 3, blk = i0 + bl;
    float zf[16];
    {   f32x16 acc;
#pragma unroll
        for (int r = 0; r < 16; ++r) acc[r] = 0.f;
        hy_conv_mfma(lds, i0, lane, acc);
        const float w0 = cw[c], w1 = cw[3072 + c], w2 = cw[2 * 3072 + c], b0 = cb[c];
#pragma unroll
        for (int g = 0; g < 4; ++g) { const int t0 = 32 * blk + 8 * g + 4 * hh;
            const u32x2 zo = *(const LAS u32x2*)(lds + HYZ_OFF + (blk + 7) * HYZ_PITCH + g * 64 + b * 16 + 8 * hh);
            float x1[4]; hy_cv4(PB + (size_t)c * M + b * T, t0, w0, w1, w2, b0, x1);
            zf[4 * g + 0] = x1[0] * (acc[4 * g + 0] + bd0 * bflo(zo.x)); zf[4 * g + 1] = x1[1] * (acc[4 * g + 1] + bd0 * bfhi(zo.x));
            zf[4 * g + 2] = x1[2] * (acc[4 * g + 2] + bd0 * bflo(zo.y)); zf[4 * g + 3] = x1[3] * (acc[4 * g + 3] + bd0 * bfhi(zo.y)); }
    }
    __syncthreads();
#pragma unroll
    for (int g = 0; g < 4; ++g) { u32x2 pk; pk.x = pk2(zf[4 * g], zf[4 * g + 1]); pk.y = pk2(zf[4 * g + 2], zf[4 * g + 3]);
        *(LAS u32x2*)(lds + HYZ_OFF + (blk + 7) * HYZ_PITCH + g * 64 + b * 16 + 8 * hh) = pk; }
    hy_build_taps(lds, hf + (size_t)1024 * 4096, tid);
    {   f32x16 acc;
#pragma unroll
        for (int r = 0; r < 16; ++r) acc[r] = 0.f;
        hy_conv_mfma(lds, i0, lane, acc);
        const int ch = 1024 + c; const float w0 = cw[ch], w1 = cw[3072 + ch], w2 = cw[2 * 3072 + ch], b0 = cb[ch];
        bf16_t* YB = (bf16_t*)(ws + WS_YB);
#pragma unroll
        for (int g = 0; g < 4; ++g) { const int t0 = 32 * blk + 8 * g + 4 * hh;
            float x2[4]; hy_cv4(PB + (size_t)ch * M + b * T, t0, w0, w1, w2, b0, x2);
#pragma unroll
            for (int q = 0; q < 4; ++q) YB[(size_t)(b * T + t0 + q) * 1024 + c] = (bf16_t)f2bf(x2[q] * (acc[4 * g + q] + bd1 * zf[4 * g + q])); }
    }
}

__device__ __forceinline__ float softplusf_(float x) { return fmaxf(x, 0.f) + log1pf(expf(-fabsf(x))); }
__device__ __forceinline__ float rw_mix(const bf16_t* PC, int tok, int x, float mp, float mn) {
    const int t = tok & (T - 1);
    const float c = bf2f(PC[(size_t)tok * CINP + x]);
    const float p = t > 0 ? bf2f(PC[(size_t)(tok - 1) * CINP + x]) : 0.f;
    const float n = t < T - 1 ? bf2f(PC[(size_t)(tok + 1) * CINP + x]) : 0.f;
    return c + mp * (p - c) + mn * (n - c);
}
__device__ __forceinline__ void rwkv_prep_unit(const PT& a, int l, int u, LAS unsigned char* lds) {
    unsigned char* ws = a.ws();
    const int tid = opaque_tid();
    const int tok0 = u * 8;
    const bf16_t* PC = (const bf16_t*)(ws + WS_PC);
    const float* mup = a.in(I_RW_MU_PREV) + (size_t)l * CIN; const float* mun = a.in(I_RW_MU_NEXT) + (size_t)l * CIN;
    LAS float* sg = (LAS float*)lds;
    LAS float* tw = sg + 8 * 128;
    LAS float* ad = tw + 8 * 96;
    LAS float* vv1 = ad + 8 * 96;
    LAS float* vmx = vv1 + 8 * 32;
    __syncthreads();
    for (int e = tid; e < 8 * 320; e += NTHREADS) { const int j = e / 320, xx = e - j * 320, x = 3072 + xx;
        const float c = rw_mix(PC, tok0 + j, x, mup[x], mun[x]);
        if (xx < 128) sg[j * 128 + xx] = sigmoidf_(c); else if (xx < 224) tw[j * 96 + (xx - 128)] = tanhf(c); else ad[j * 96 + (xx - 224)] = c; }
    if (l > 0) {
        for (int e = tid; e < 8 * 1024; e += NTHREADS) { const int j = e >> 10, ch = e & 1023; vmx[e] = rw_mix(PC, tok0 + j, 2048 + ch, mup[2048 + ch], mun[2048 + ch]); }
        __syncthreads();
        if (tid < 256) { const int j = tid >> 5, r = tid & 31; const float* v1 = a.in(I_RW_V1) + (size_t)(l - 1) * 1024 * VL; float acc = 0.f;
            for (int c = 0; c < 1024; ++c) acc += vmx[j * 1024 + c] * v1[c * VL + r];
            vv1[j * 32 + r] = acc; }
    }
    __syncthreads();
    float *Rb = (float*)(ws + WS_R), *Vb = (float*)(ws + WS_V), *Ab = (float*)(ws + WS_AA), *Wb = (float*)(ws + WS_WD), *Kb = (float*)(ws + WS_KD), *Bb = (float*)(ws + WS_BD),
          *Gb = (float*)(ws + WS_GG), *VF = (float*)(ws + WS_VFIRST);
#pragma unroll 1
    for (int half = 0; half < 2; ++half) {
        const int ch = tid + NTHREADS * half;
        float accw[2][8], acca[2][8], accg[8], accv[8];
#pragma unroll
        for (int j = 0; j < 8; ++j) { accw[0][j] = accw[1][j] = acca[0][j] = acca[1][j] = accg[j] = accv[j] = 0.f; }
        { const float* w2 = a.in(I_RW_W2) + (size_t)l * 2 * WL * 1024; const float* a2 = a.in(I_RW_A2) + (size_t)l * 2 * AL * 1024;
#pragma unroll
          for (int d = 0; d < 2; ++d)
            for (int r = 0; r < 48; ++r) { const float ww = w2[(size_t)(d * 48 + r) * 1024 + ch], wa = a2[(size_t)(d * 48 + r) * 1024 + ch];
#pragma unroll
                for (int j = 0; j < 8; ++j) { accw[d][j] += tw[j * 96 + d * 48 + r] * ww; acca[d][j] += ad[j * 96 + d * 48 + r] * wa; } } }
        { const float* g2 = a.in(I_RW_G2) + (size_t)l * GL * 1024;
          for (int r = 0; r < GL; ++r) { const float w = g2[(size_t)r * 1024 + ch];
#pragma unroll
              for (int j = 0; j < 8; ++j) accg[j] += sg[j * 128 + r] * w; } }
        if (l > 0) { const float* v2 = a.in(I_RW_V2) + (size_t)(l - 1) * VL * 1024;
          for (int r = 0; r < VL; ++r) { const float w = v2[(size_t)r * 1024 + ch];
#pragma unroll
              for (int j = 0; j < 8; ++j) accv[j] += vv1[j * 32 + r] * w; } }
        const float w00 = a.in(I_RW_W0)[(l * 2 + 0) * 1024 + ch], w01 = a.in(I_RW_W0)[(l * 2 + 1) * 1024 + ch];
        const float a00 = a.in(I_RW_A0)[(l * 2 + 0) * 1024 + ch], a01 = a.in(I_RW_A0)[(l * 2 + 1) * 1024 + ch];
        const float kkw = a.in(I_RW_K_K)[l * 1024 + ch], kaw = a.in(I_RW_K_A)[l * 1024 + ch];
        const float v0w = l > 0 ? a.in(I_RW_V0)[(l - 1) * 1024 + ch] : 0.f;
        const float mpr = mup[ch], mnr = mun[ch], mpk = mup[1024 + ch], mnk = mun[1024 + ch], mpv = mup[2048 + ch], mnv = mun[2048 + ch];
#pragma unroll
        for (int j = 0; j < 8; ++j) {
            const int tok = tok0 + j; const size_t o = (size_t)tok * 1024 + ch;
            const float r = rw_mix(PC, tok, ch, mpr, mnr), k = rw_mix(PC, tok, 1024 + ch, mpk, mnk);
            float v;
            if (l == 0) { v = rw_mix(PC, tok, 2048 + ch, mpv, mnv); VF[o] = v; }
            else { v = vmx[j * 1024 + ch]; v = v + (VF[o] - v) * sigmoidf_(v0w + accv[j]); }
            float kk = k * kkw; const float ss = wave_sum(kk * kk); kk = kk / fmaxf(sqrtf(ss), 1e-12f);
            Rb[o] = r; Vb[o] = v; Ab[o] = -kk; Gb[o] = accg[j];
#pragma unroll
            for (int d = 0; d < 2; ++d) {
                const float wl = -softplusf_(-((d ? w01 : w00) + accw[d][j])) - 0.5f;
                const float decay = expf(-expf(wl));
                const float aa = sigmoidf_((d ? a01 : a00) + acca[d][j]);
                const size_t od = (size_t)d * M * 1024 + o;
                Wb[od] = decay; Kb[od] = k * (1.f + (aa - 1.f) * kaw); Bb[od] = kk * aa;
            }
        }
    }
}

constexpr int ACT_PITCH = 848, VMX_PITCH = 2064, PREP_ACT_OFF = 0, PREP_VMX_OFF = 32 * ACT_PITCH, PREP_PART_OFF = PREP_VMX_OFF + 32 * VMX_PITCH;
__device__ __forceinline__ float red16d(float v) { v += dpp_mov<0xB1>(v); v += dpp_mov<0x4E>(v); v += dpp_mov<0x141>(v); v += dpp_mov<0x140>(v); return v; }
__device__ __forceinline__ void rw_mix4(const bf16_t* PC, int tok0, int x, float mp, float mn, float (&o)[4]) {
    const int t0 = tok0 & (T - 1); const bf16_t* p = PC + (size_t)tok0 * CINP + x;
    float c[6];
    c[0] = t0 > 0 ? bf2f(p[-(ptrdiff_t)CINP]) : 0.f;
#pragma unroll
    for (int q = 0; q < 4; ++q) c[1 + q] = bf2f(p[(size_t)q * CINP]);
    c[5] = t0 + 4 < T ? bf2f(p[(size_t)4 * CINP]) : 0.f;
#pragma unroll
    for (int q = 0; q < 4; ++q) o[q] = c[1 + q] + mp * (c[q] - c[1 + q]) + mn * (c[2 + q] - c[1 + q]);
}
__device__ __forceinline__ void rwkv_prep_unit2(const PT& a, int l, int u, LAS unsigned char* lds) {
    unsigned char* ws = a.ws();
    const int tid = opaque_tid(), lane = tid & 63, wave = __builtin_amdgcn_readfirstlane(tid >> 6);
    const int tokb = u * 32;
    const bf16_t* PC = (const bf16_t*)(ws + WS_PC);
    const float* mup = a.in(I_RW_MU_PREV) + (size_t)l * CIN; const float* mun = a.in(I_RW_MU_NEXT) + (size_t)l * CIN;
    __syncthreads();
    for (int e = tid; e < 32 * 4 * 16; e += NTHREADS) { const int j = e >> 6, seg = (e >> 4) & 3, r = 48 + (e & 15); *(LAS bf16_t*)(lds + PREP_ACT_OFF + j * ACT_PITCH + (seg * 64 + r) * 2) = 0; }
    for (int e = tid; e < 32 * 320; e += NTHREADS) { const int j = e / 320, xx = e - j * 320, x = 3072 + xx; const int tok = tokb + j, t = tok & (T - 1);
        const float c = bf2f(PC[(size_t)tok * CINP + x]); const float p = t > 0 ? bf2f(PC[(size_t)(tok - 1) * CINP + x]) : 0.f; const float n = t < T - 1 ? bf2f(PC[(size_t)(tok + 1) * CINP + x]) : 0.f;
        const float m = c + mup[x] * (p - c) + mun[x] * (n - c);
        int kk; float val;
        if (xx < 128) { kk = 256 + xx; val = sigmoidf_(m); }
        else if (xx < 224) { const int q = xx - 128, d = q >= 48; kk = d * 64 + (q - 48 * d); val = tanhf(m); }
        else { const int q = xx - 224, d = q >= 48; kk = 128 + d * 64 + (q - 48 * d); val = m; }
        *(LAS bf16_t*)(lds + PREP_ACT_OFF + j * ACT_PITCH + kk * 2) = (bf16_t)f2bf(val); }
    if (l > 0) {
        for (int e = tid; e < 32 * 128; e += NTHREADS) { const int j = e >> 7, c8 = (e & 127) * 8; const int tok = tokb + j, t = tok & (T - 1);
            const bf16_t* p = PC + (size_t)tok * CINP + 2048 + c8;
            const u32x4 cc = *(const u32x4*)p; u32x4 pp = {0u, 0u, 0u, 0u}, nn = {0u, 0u, 0u, 0u};
            if (t > 0) pp = *(const u32x4*)(p - CINP); if (t < T - 1) nn = *(const u32x4*)(p + CINP);
            float o[8];
#pragma unroll
            for (int q = 0; q < 4; ++q) { const float c0 = bflo(cc[q]), c1 = bfhi(cc[q]);
                o[2 * q] = c0 + mup[2048 + c8 + 2 * q] * (bflo(pp[q]) - c0) + mun[2048 + c8 + 2 * q] * (bflo(nn[q]) - c0);
                o[2 * q + 1] = c1 + mup[2048 + c8 + 2 * q + 1] * (bfhi(pp[q]) - c1) + mun[2048 + c8 + 2 * q + 1] * (bfhi(nn[q]) - c1); }
            u32x4 w; w.x = pk2(o[0], o[1]); w.y = pk2(o[2], o[3]); w.z = pk2(o[4], o[5]); w.w = pk2(o[6], o[7]);
            *(LAS u32x4*)(lds + PREP_VMX_OFF + j * VMX_PITCH + c8 * 2) = w; }
    }
    __syncthreads();
    const int l15 = lane & 15, lq = lane >> 4;
    if (l > 0) {
        const int tm = wave & 1, tn = (wave >> 1) & 1, kh = wave >> 2;
        const bf16_t* V1T = (const bf16_t*)(ws + WS_V1T) + (size_t)(l - 1) * 32 * 1024 + (size_t)(16 * tn + l15) * 1024 + kh * 512 + 8 * lq;
        const LAS unsigned char* ap = lds + PREP_VMX_OFF + (16 * tm + l15) * VMX_PITCH + (kh * 512 + 8 * lq) * 2;
        f32x4 acc = {0.f, 0.f, 0.f, 0.f};
#pragma unroll 4
        for (int ks = 0; ks < 16; ++ks) { const bf16x8 af = *(const LAS bf16x8*)(ap + ks * 64); const bf16x8 bfr = *(const bf16x8*)(V1T + ks * 32);
            acc = __builtin_amdgcn_mfma_f32_16x16x32_bf16(af, bfr, acc, 0, 0, 0); }
        *(LAS f32x4*)(lds + PREP_PART_OFF + wave * 1024 + lane * 16) = acc;
        __syncthreads();
        if (wave < 4) { const f32x4 p0 = *(const LAS f32x4*)(lds + PREP_PART_OFF + wave * 1024 + lane * 16), p1 = *(const LAS f32x4*)(lds + PREP_PART_OFF + (wave + 4) * 1024 + lane * 16);
#pragma unroll
            for (int r = 0; r < 4; ++r) *(LAS bf16_t*)(lds + PREP_ACT_OFF + (16 * tm + 4 * lq + r) * ACT_PITCH + (384 + 16 * tn + l15) * 2) = (bf16_t)f2bf(p0[r] + p1[r]); }
        __syncthreads();
    }
    float *Rb = (float*)(ws + WS_R), *Vb = (float*)(ws + WS_V), *Ab = (float*)(ws + WS_AA), *Wb = (float*)(ws + WS_WD), *Kb = (float*)(ws + WS_KD), *Bb = (float*)(ws + WS_BD),
          *Gb = (float*)(ws + WS_GG), *VF = (float*)(ws + WS_VFIRST);
    const bf16_t* WL = (const bf16_t*)(ws + WS_WLORA) + (size_t)l * 1024 * LORA_K;
#pragma unroll 1
    for (int hb = 0; hb < 4; ++hb) {
        const int head = 2 * wave + (hb >> 1), th = hb & 1;
        bf16x8 af[13];
        { const LAS unsigned char* ap = lds + PREP_ACT_OFF + (16 * th + l15) * ACT_PITCH + 16 * lq;
#pragma unroll
          for (int ks = 0; ks < 13; ++ks) af[ks] = *(const LAS bf16x8*)(ap + ks * 64); }
        f32x4 acc[4][6];
#pragma unroll
        for (int ct = 0; ct < 4; ++ct) {
            const bf16_t* wrow = WL + (size_t)(head * 64 + 16 * ct + l15) * LORA_K + 8 * lq;
#pragma unroll
            for (int kd = 0; kd < 6; ++kd) acc[ct][kd] = (f32x4){0.f, 0.f, 0.f, 0.f};
#pragma unroll
            for (int ks = 0; ks < 13; ++ks) { const int kd = ks < 8 ? (ks >> 1) : (ks < 12 ? 4 : 5);
                if (kd == 5 && l == 0) continue;
                const bf16x8 bfr = *(const bf16x8*)(wrow + ks * 32);
                acc[ct][kd] = __builtin_amdgcn_mfma_f32_16x16x32_bf16(af[ks], bfr, acc[ct][kd], 0, 0, 0); }
        }
        const int tok0 = tokb + 16 * th + 4 * lq;
        float kmix[4][4], ssq[4] = {0.f, 0.f, 0.f, 0.f};
#pragma unroll
        for (int ct = 0; ct < 4; ++ct) { const int ch = head * 64 + 16 * ct + l15; rw_mix4(PC, tok0, 1024 + ch, mup[1024 + ch], mun[1024 + ch], kmix[ct]);
            const float kkw = a.in(I_RW_K_K)[l * 1024 + ch];
#pragma unroll
            for (int r = 0; r < 4; ++r) { const float kk = kmix[ct][r] * kkw; ssq[r] += kk * kk; } }
        float rn[4];
#pragma unroll
        for (int r = 0; r < 4; ++r) rn[r] = 1.f / fmaxf(sqrtf(red16d(ssq[r])), 1e-12f);
#pragma unroll
        for (int ct = 0; ct < 4; ++ct) { const int ch = head * 64 + 16 * ct + l15;
            float rmix[4], vmix[4]; rw_mix4(PC, tok0, ch, mup[ch], mun[ch], rmix); rw_mix4(PC, tok0, 2048 + ch, mup[2048 + ch], mun[2048 + ch], vmix);
            const float w00 = a.in(I_RW_W0)[(l * 2 + 0) * 1024 + ch], w01 = a.in(I_RW_W0)[(l * 2 + 1) * 1024 + ch];
            const float a00 = a.in(I_RW_A0)[(l * 2 + 0) * 1024 + ch], a01 = a.in(I_RW_A0)[(l * 2 + 1) * 1024 + ch];
            const float kkw = a.in(I_RW_K_K)[l * 1024 + ch], kaw = a.in(I_RW_K_A)[l * 1024 + ch];
            const float v0w = l > 0 ? a.in(I_RW_V0)[(l - 1) * 1024 + ch] : 0.f;
#pragma unroll
            for (int r = 0; r < 4; ++r) { const size_t o = (size_t)(tok0 + r) * 1024 + ch;
                float v = vmix[r];
                if (l == 0) VF[o] = v; else v = v + (VF[o] - v) * sigmoidf_(v0w + acc[ct][5][r]);
                const float k = kmix[ct][r], kk = k * kkw * rn[r];
                Rb[o] = rmix[r]; Vb[o] = v; Ab[o] = -kk; Gb[o] = acc[ct][4][r];
#pragma unroll
                for (int d = 0; d < 2; ++d) {
                    const float wl = -softplusf_(-((d ? w01 : w00) + acc[ct][d][r])) - 0.5f;
                    const float decay = expf(-expf(wl));
                    const float aa = sigmoidf_((d ? a01 : a00) + acc[ct][2 + d][r]);
                    const size_t od = (size_t)d * M * 1024 + o;
                    Wb[od] = decay; Kb[od] = k * (1.f + (aa - 1.f) * kaw); Bb[od] = kk * aa; } }
        }
    }
}

struct ScanIn { f32x4 a0, a1, w0, w1, b0, b1, k0, k1, r0, r1; float v; };
__device__ __forceinline__ void scan_load(ScanIn& s, const float* Ab, const float* Wb, const float* Bb, const float* Kb, const float* Rb, const float* Vb, size_t base, int cg, int row) {
    const size_t o = base + cg * 8;
    s.a0 = *(const f32x4*)(Ab + o); s.a1 = *(const f32x4*)(Ab + o + 4); s.w0 = *(const f32x4*)(Wb + o); s.w1 = *(const f32x4*)(Wb + o + 4);
    s.b0 = *(const f32x4*)(Bb + o); s.b1 = *(const f32x4*)(Bb + o + 4); s.k0 = *(const f32x4*)(Kb + o); s.k1 = *(const f32x4*)(Kb + o + 4);
    s.r0 = *(const f32x4*)(Rb + o); s.r1 = *(const f32x4*)(Rb + o + 4); s.v = Vb[base + row];
}
__device__ __forceinline__ float red8(float v) { v += __shfl_xor(v, 1); v += __shfl_xor(v, 2); v += __shfl_xor(v, 4); return v; }
__device__ __forceinline__ void wkv_scan_seq(const PT& a, int seq) {
    unsigned char* ws = a.ws();
    const int tid = opaque_tid(), lane = tid & 63, wave = tid >> 6;
    const int dir = seq >> 6, b = (seq >> 4) & 3, h = seq & 15;
    const int cg = lane & 7, row = wave * 8 + (lane >> 3);
    const float *Rb = (const float*)(ws + WS_R), *Vb = (const float*)(ws + WS_V), *Ab = (const float*)(ws + WS_AA);
    const float *Wb = (const float*)(ws + WS_WD) + (size_t)dir * M * 1024, *Kb = (const float*)(ws + WS_KD) + (size_t)dir * M * 1024, *Bb = (const float*)(ws + WS_BD) + (size_t)dir * M * 1024;
    float* Y = (float*)(ws + WS_YS) + (size_t)dir * M * 1024;
    f32x4 S0 = {0.f, 0.f, 0.f, 0.f}, S1 = {0.f, 0.f, 0.f, 0.f};
    ScanIn cur, nxt;
    { const int tt = dir ? T - 1 : 0; scan_load(cur, Ab, Wb, Bb, Kb, Rb, Vb, (size_t)(b * T + tt) * 1024 + h * 64, cg, row); }
    for (int step = 0; step < T; ++step) {
        const int tt = dir ? T - 1 - step : step;
        const int sn = step + 1 < T ? step + 1 : step; const int tn = dir ? T - 1 - sn : sn;
        scan_load(nxt, Ab, Wb, Bb, Kb, Rb, Vb, (size_t)(b * T + tn) * 1024 + h * 64, cg, row);
        float sa = S0[0] * cur.a0[0] + S0[1] * cur.a0[1] + S0[2] * cur.a0[2] + S0[3] * cur.a0[3] + S1[0] * cur.a1[0] + S1[1] * cur.a1[1] + S1[2] * cur.a1[2] + S1[3] * cur.a1[3];
        sa = red8(sa);
        S0 = S0 * cur.w0 + sa * cur.b0 + cur.v * cur.k0;
        S1 = S1 * cur.w1 + sa * cur.b1 + cur.v * cur.k1;
        float y = S0[0] * cur.r0[0] + S0[1] * cur.r0[1] + S0[2] * cur.r0[2] + S0[3] * cur.r0[3] + S1[0] * cur.r1[0] + S1[1] * cur.r1[1] + S1[2] * cur.r1[2] + S1[3] * cur.r1[3];
        y = red8(y);
        if (cg == 0) Y[(size_t)(b * T + tt) * 1024 + h * 64 + row] = y;
        cur = nxt;
    }
}

constexpr int SC_TC = 32, SC_STEP_F = 384, SC_BUF_F = SC_TC * SC_STEP_F;
__device__ __forceinline__ float red8d(float v) { v += dpp_mov<0xB1>(v); v += dpp_mov<0x4E>(v); v += dpp_mov<0x141>(v); return v; }
__device__ __forceinline__ float dot8(const f32x4& s0, const f32x4& s1, const f32x4& x0, const f32x4& x1) {
    const f32x4 p = s0 * x0 + s1 * x1; return (p[0] + p[1]) + (p[2] + p[3]); }
__device__ __forceinline__ void scan_stage_chunk(LAS float* dst, int lt, int c, int dir, int b, int h, const float* pa, const float* pw, const float* pb, const float* pk, const float* pr, const float* pv) {
    f32x4 val[12];
#pragma unroll
    for (int i = 0; i < 12; ++i) { const int e = lt + 256 * i; const int step = e / 96, rem = e - 96 * step, vec = rem >> 4, q = rem & 15;
        const int gs = c * SC_TC + step; const int tt = dir ? T - 1 - gs : gs;
        const float* base = vec == 0 ? pa : (vec == 1 ? pw : (vec == 2 ? pb : (vec == 3 ? pk : (vec == 4 ? pr : pv))));
        val[i] = *(const f32x4*)(base + (size_t)(b * T + tt) * 1024 + h * 64 + q * 4); }
#pragma unroll
    for (int i = 0; i < 12; ++i) { const int e = lt + 256 * i; const int step = e / 96, rem = e - 96 * step;
        *(LAS f32x4*)(dst + step * SC_STEP_F + rem * 4) = val[i]; }
}
__device__ __forceinline__ void wkv_scan_seq2(const PT& a, int seq, LAS unsigned char* lds) {
    unsigned char* ws = a.ws();
    const int tid = opaque_tid(), lane = tid & 63, wave = __builtin_amdgcn_readfirstlane(tid >> 6);
    const int dir = seq >> 6, b = (seq >> 4) & 3, h = seq & 15;
    LAS float* buf = (LAS float*)lds;
    const float *pr = (const float*)(ws + WS_R), *pv = (const float*)(ws + WS_V), *pa = (const float*)(ws + WS_AA);
    const float *pw = (const float*)(ws + WS_WD) + (size_t)dir * M * 1024, *pk = (const float*)(ws + WS_KD) + (size_t)dir * M * 1024, *pb = (const float*)(ws + WS_BD) + (size_t)dir * M * 1024;
    float* Y = (float*)(ws + WS_YS) + (size_t)dir * M * 1024;
    const int cg = lane & 7, row0 = wave * 16 + 2 * (lane >> 3);
    f32x4 S00 = {0.f, 0.f, 0.f, 0.f}, S01 = S00, S10 = S00, S11 = S00;
    __syncthreads();
    if (wave >= 4) scan_stage_chunk(buf, tid - 256, 0, dir, b, h, pa, pw, pb, pk, pr, pv);
    __syncthreads();
#pragma unroll 1
    for (int c = 0; c < T / SC_TC; ++c) {
        if (wave >= 4) { if (c + 1 < T / SC_TC) scan_stage_chunk(buf + ((c + 1) & 1) * SC_BUF_F, tid - 256, c + 1, dir, b, h, pa, pw, pb, pk, pr, pv); }
        else {
            const LAS float* cb = buf + (c & 1) * SC_BUF_F + cg * 8;
            const LAS float* vb = buf + (c & 1) * SC_BUF_F + 320 + row0;
#pragma unroll 4
            for (int s = 0; s < SC_TC; ++s) {
                const LAS float* p = cb + s * SC_STEP_F;
                const f32x4 a0 = *(const LAS f32x4*)(p), a1 = *(const LAS f32x4*)(p + 4), w0 = *(const LAS f32x4*)(p + 64), w1 = *(const LAS f32x4*)(p + 68);
                const f32x4 b0 = *(const LAS f32x4*)(p + 128), b1 = *(const LAS f32x4*)(p + 132), k0 = *(const LAS f32x4*)(p + 192), k1 = *(const LAS f32x4*)(p + 196);
                const f32x4 r0 = *(const LAS f32x4*)(p + 256), r1 = *(const LAS f32x4*)(p + 260);
                const f32x2 vv = *(const LAS f32x2*)(vb + s * SC_STEP_F);
                const float sa0 = red8d(dot8(S00, S01, a0, a1)), sa1 = red8d(dot8(S10, S11, a0, a1));
                S00 = S00 * w0 + sa0 * b0 + vv[0] * k0; S01 = S01 * w1 + sa0 * b1 + vv[0] * k1;
                S10 = S10 * w0 + sa1 * b0 + vv[1] * k0; S11 = S11 * w1 + sa1 * b1 + vv[1] * k1;
                const float y0 = red8d(dot8(S00, S01, r0, r1)), y1 = red8d(dot8(S10, S11, r0, r1));
                const int gs = c * SC_TC + s; const int tt = dir ? T - 1 - gs : gs;
                if (cg == 0) *(f32x2*)(Y + (size_t)(b * T + tt) * 1024 + h * 64 + row0) = (f32x2){y0, y1};
            }
        }
        __syncthreads();
    }
}

constexpr int S3_TC = 16, S3_BUF_F = S3_TC * SC_STEP_F;
constexpr int S3_YOFF = 2 * S3_BUF_F * 4, S3_YBUF = S3_TC * 4 * 64 * 8;
struct ScanVec { f32x4 a0, a1, w0, w1, b0, b1, k0, k1, r0, r1; f32x2 v; };
__device__ __forceinline__ void scan_lds_load(ScanVec& x, const LAS float* p, const LAS float* pv) {
    x.a0 = *(const LAS f32x4*)(p); x.a1 = *(const LAS f32x4*)(p + 4); x.w0 = *(const LAS f32x4*)(p + 64); x.w1 = *(const LAS f32x4*)(p + 68);
    x.b0 = *(const LAS f32x4*)(p + 128); x.b1 = *(const LAS f32x4*)(p + 132); x.k0 = *(const LAS f32x4*)(p + 192); x.k1 = *(const LAS f32x4*)(p + 196);
    x.r0 = *(const LAS f32x4*)(p + 256); x.r1 = *(const LAS f32x4*)(p + 260); x.v = *(const LAS f32x2*)(pv);
}
__device__ __forceinline__ void scan_stage_chunk3(LAS float* dst, int lt, int c, int dir, int b, int h, const float* pa, const float* pw, const float* pb, const float* pk, const float* pr, const float* pv) {
    f32x4 val[6];
#pragma unroll
    for (int i = 0; i < 6; ++i) { const int e = lt + 256 * i; const int step = e / 96, rem = e - 96 * step, vec = rem >> 4, q = rem & 15;
        const int gs = c * S3_TC + step; const int tt = dir ? T - 1 - gs : gs;
        const float* base = vec == 0 ? pa : (vec == 1 ? pw : (vec == 2 ? pb : (vec == 3 ? pk : (vec == 4 ? pr : pv))));
        val[i] = *(const f32x4*)(base + (size_t)(b * T + tt) * 1024 + h * 64 + q * 4); }
#pragma unroll
    for (int i = 0; i < 6; ++i) { const int e = lt + 256 * i; const int step = e / 96, rem = e - 96 * step;
        *(LAS f32x4*)(dst + step * SC_STEP_F + rem * 4) = val[i]; }
}
__device__ __forceinline__ void scan_reduce_y(const LAS unsigned char* yb, int lt, int c, int dir, int b, int h, float* Y) {
#pragma unroll
    for (int i = 0; i < 2; ++i) { const int e = lt + 256 * i; const int s = e >> 5, wv = (e >> 3) & 3, rp = e & 7;
        const LAS f32x4* p = (const LAS f32x4*)(yb + ((s * 4 + wv) * 64 + rp * 8) * 8);
        const f32x4 q0 = p[0], q1 = p[1], q2 = p[2], q3 = p[3];
        const float y0 = ((q0[0] + q0[2]) + (q1[0] + q1[2])) + ((q2[0] + q2[2]) + (q3[0] + q3[2]));
        const float y1 = ((q0[1] + q0[3]) + (q1[1] + q1[3])) + ((q2[1] + q2[3]) + (q3[1] + q3[3]));
        const int gs = c * S3_TC + s; const int tt = dir ? T - 1 - gs : gs;
        *(f32x2*)(Y + (size_t)(b * T + tt) * 1024 + h * 64 + wv * 16 + 2 * rp) = (f32x2){y0, y1}; }
}
__device__ __forceinline__ void scan_step(f32x4& S00, f32x4& S01, f32x4& S10, f32x4& S11, const ScanVec& x, LAS f32x2* yp) {
    const float sa0 = red8d(dot8(S00, S01, x.a0, x.a1)), sa1 = red8d(dot8(S10, S11, x.a0, x.a1));
    S00 = S00 * x.w0 + sa0 * x.b0 + x.v[0] * x.k0; S01 = S01 * x.w1 + sa0 * x.b1 + x.v[0] * x.k1;
    S10 = S10 * x.w0 + sa1 * x.b0 + x.v[1] * x.k0; S11 = S11 * x.w1 + sa1 * x.b1 + x.v[1] * x.k1;
    *yp = (f32x2){dot8(S00, S01, x.r0, x.r1), dot8(S10, S11, x.r0, x.r1)};
}
__device__ __forceinline__ void wkv_scan_seq3(const PT& a, int seq, LAS unsigned char* lds) {
    unsigned char* ws = a.ws();
    const int tid = opaque_tid(), lane = tid & 63, wave = __builtin_amdgcn_readfirstlane(tid >> 6);
    const int dir = seq >> 6, b = (seq >> 4) & 3, h = seq & 15;
    LAS float* buf = (LAS float*)lds;
    const float *pr = (const float*)(ws + WS_R), *pv = (const float*)(ws + WS_V), *pa = (const float*)(ws + WS_AA);
    const float *pw = (const float*)(ws + WS_WD) + (size_t)dir * M * 1024, *pk = (const float*)(ws + WS_KD) + (size_t)dir * M * 1024, *pb = (const float*)(ws + WS_BD) + (size_t)dir * M * 1024;
    float* Y = (float*)(ws + WS_YS) + (size_t)dir * M * 1024;
    const int cg = lane & 7, row0 = (wave & 3) * 16 + 2 * (lane >> 3);
    f32x4 S00 = {0.f, 0.f, 0.f, 0.f}, S01 = S00, S10 = S00, S11 = S00;
    constexpr int NCH = T / S3_TC;
    __syncthreads();
    if (wave >= 4) scan_stage_chunk3(buf, tid - 256, 0, dir, b, h, pa, pw, pb, pk, pr, pv);
    __syncthreads();
#pragma unroll 1
    for (int c = 0; c < NCH; ++c) {
        if (wave >= 4) {
            if (c + 1 < NCH) scan_stage_chunk3(buf + ((c + 1) & 1) * S3_BUF_F, tid - 256, c + 1, dir, b, h, pa, pw, pb, pk, pr, pv);
            if (c > 0) scan_reduce_y(lds + S3_YOFF + ((c - 1) & 1) * S3_YBUF, tid - 256, c - 1, dir, b, h, Y);
        } else {
            const LAS float* cb = buf + (c & 1) * S3_BUF_F + cg * 8;
            const LAS float* vb = buf + (c & 1) * S3_BUF_F + 320 + row0;
            LAS f32x2* yp = (LAS f32x2*)(lds + S3_YOFF + (c & 1) * S3_YBUF) + wave * 64 + lane;
            ScanVec x0, x1;
            scan_lds_load(x0, cb, vb);
#pragma unroll
            for (int s = 0; s < S3_TC; s += 2) {
                scan_lds_load(x1, cb + (s + 1) * SC_STEP_F, vb + (s + 1) * SC_STEP_F);
                scan_step(S00, S01, S10, S11, x0, yp + s * 256);
                if (s + 2 < S3_TC) scan_lds_load(x0, cb + (s + 2) * SC_STEP_F, vb + (s + 2) * SC_STEP_F);
                scan_step(S00, S01, S10, S11, x1, yp + (s + 1) * 256);
            }
        }
        __syncthreads();
    }
    if (wave >= 4) scan_reduce_y(lds + S3_YOFF + ((NCH - 1) & 1) * S3_YBUF, tid - 256, NCH - 1, dir, b, h, Y);
}

__device__ __forceinline__ void rwkv_post_phase(const PT& a, int l) {
    unsigned char* ws = a.ws();
    const int tid = opaque_tid();
    const float *Rb = (const float*)(ws + WS_R), *Vb = (const float*)(ws + WS_V), *Kb = (const float*)(ws + WS_KD), *Gb = (const float*)(ws + WS_GG), *Y = (const float*)(ws + WS_YS);
    bf16_t* YC = (bf16_t*)(ws + WS_YC);
    for (int tok = blockIdx.x; tok < M; tok += gridDim.x) {
#pragma unroll
        for (int half = 0; half < 2; ++half) {
            const int ch = tid + NTHREADS * half; const size_t o = (size_t)tok * 1024 + ch;
            const float y = Y[o] + Y[(size_t)M * 1024 + o];
            const float mu = wave_sum(y) * (1.f / 64.f); const float d = y - mu; const float var = wave_sum(d * d) * (1.f / 64.f);
            const float yn = d * (1.f / sqrtf(var + GN_EPS)) * a.in(I_RW_LN_G)[l * 1024 + ch] + a.in(I_RW_LN_B)[l * 1024 + ch];
            const float r = Rb[o]; const float bon = wave_sum(r * (Kb[o] + Kb[(size_t)M * 1024 + o]) * a.in(I_RW_R_K)[l * 1024 + ch]);
            const float out = (yn + bon * Vb[o]) * Gb[o];
            YC[o] = (bf16_t)f2bf(out);
        }
    }
}

__device__ __forceinline__ void merge_phase(const PT& a) {
    unsigned char* ws = a.ws();
    const size_t gt = (size_t)blockIdx.x * NTHREADS + opaque_tid(), NGT = (size_t)gridDim.x * NTHREADS;
    const bf16_t* PG = (const bf16_t*)(ws + WS_PG); const bf16_t* PBR = (const bf16_t*)(ws + WS_PBR); bf16_t* MG = (bf16_t*)(ws + WS_MERGED);
    for (size_t i = gt; i < (size_t)M * D / 8; i += NGT) {
        const size_t m = i / (D / 8), c = (i % (D / 8)) * 8;
        float acc[8];
#pragma unroll
        for (int j = 0; j < 8; ++j) acc[j] = 0.f;
#pragma unroll
        for (int br = 0; br < 3; ++br) {
            const u32x4 g = *(const u32x4*)(PG + m * 6144 + br * 2048 + c); const u32x4 p = *(const u32x4*)(PBR + ((size_t)br * M + m) * D + c);
#pragma unroll
            for (int j = 0; j < 4; ++j) { acc[2 * j] += bflo(g[j]) * bflo(p[j]); acc[2 * j + 1] += bfhi(g[j]) * bfhi(p[j]); }
        }
        u32x4 o; o.x = pk2(acc[0], acc[1]); o.y = pk2(acc[2], acc[3]); o.z = pk2(acc[4], acc[5]); o.w = pk2(acc[6], acc[7]);
        *(u32x4*)(MG + m * D + c) = o;
    }
}

constexpr int PH_PRO_A = 0, PH_PRO_B = 1, PH_LAYER0 = 2, PH_PER_LAYER = 11, PH_FINAL = PH_LAYER0 + DEPTH * PH_PER_LAYER, N_PHASES = PH_FINAL + 1;

__global__ void __launch_bounds__(NTHREADS, 2) mk_fwd(Args args) {
    extern __shared__ __attribute__((aligned(16))) unsigned char lds_raw[];
    LAS unsigned char* lds = (LAS unsigned char*)lds_raw;
    const int tid = threadIdx.x;
    volatile LAS unsigned* misc = (volatile LAS unsigned*)(lds + LDS_MISC_OFF);
    if (tid < 64) misc[tid] = 0u;
    if (tid < 64) {   LAS unsigned long long* tab = (LAS unsigned long long*)(lds + PTAB_OFF);
        unsigned long long v = 0ull;
#pragma unroll
        for (int i = 0; i < N_INPUTS; ++i) v = (tid == i) ? (unsigned long long)args.in[i] : v;
        v = (tid == N_INPUTS) ? (unsigned long long)args.out : v;
        v = (tid == N_INPUTS + 1) ? (unsigned long long)args.ws : v;
        tab[tid] = v; }
    __syncthreads();
    const PT pt{lds};
    XcdBarrier bar = xcd_barrier_post((unsigned*)(pt.ws() + WS_CTL) + CW_BAR, misc + 8);
    const int lo = args.ph_lo, hi = args.ph_hi;
    const int G = gridDim.x, bid = blockIdx.x;
#define IN(k) (lo <= (k) && (k) < hi)
#define SEAM(k) do { if ((k) + 1 < hi) xcd_barrier(bar); } while (0)
#define REP(k) for (int rep_ = 0; rep_ < (((PROBE_MASK >> (k)) & 1) ? 2 : 1); ++rep_)

    if (IN(PH_PRO_A)) { REP(11) { prologue_a(pt, lds); } SEAM(PH_PRO_A); }
    if (IN(PH_PRO_B)) { REP(12) prologue_b(pt, lds); SEAM(PH_PRO_B); }

#pragma unroll 1
    for (int l = 0; l < DEPTH; ++l) {
        const int p0 = PH_LAYER0 + l * PH_PER_LAYER;
        unsigned char* ws = pt.ws();
        float* X = (float*)(ws + WS_X); bf16_t* Hb = (bf16_t*)(ws + WS_H);
        if (IN(p0 + 0)) { REP(0) { rmsnorm_phase(X, pt.in(I_NORM_MIX_G) + l * D, Hb, nullptr); } SEAM(p0 + 0); }
        if (IN(p0 + 1)) { REP(1) {
            const bf16_t* W = (const bf16_t*)(ws + WS_WIN + l * WIN_L);
            pg8::SegOrder S{Hb, W, M / 256, NIN_MAIN / 256, W + (size_t)NIN_MAIN * D, Hb, 3 * BW / 256, M / 256, G, bid};
            pg8::EpiInProj E{(bf16_t*)(ws + WS_PA), (bf16_t*)(ws + WS_PC), (bf16_t*)(ws + WS_PG), (bf16_t*)(ws + WS_PB)};
            pg8::gemm_phase<pg8::EpiInProj>(lds, D, S, E);
            } SEAM(p0 + 1);
        }
        if (IN(p0 + 2)) { REP(2) {
            gmlp_stats_phase((const bf16_t*)(ws + WS_PA), (float*)(ws + WS_STATS));
            for (int u = bid; u < M / 32; u += G) rwkv_prep_unit2(pt, l, u, lds);
            } SEAM(p0 + 2);
        }
        if (IN(p0 + 3)) { REP(3) {
            if (G >= 256) {
                if (bid < 128) { REP(14) wkv_scan_seq3(pt, bid, lds); }
                else { const int ob = bid - 128, on = G - 128;
                    REP(13) {
                    for (int c = ob; c < BW; c += on) hyena_unit2(pt, l, c, lds);
                    for (int u = ob; u < 512; u += on) gmlp_unit2(pt, l, u, lds); }
                    if (l + 1 < DEPTH) { __syncthreads(); const int tid_ = opaque_tid(); convert_layer_weights(pt, lds, l + 1, ob * NWAVES + (tid_ >> 6), on * NWAVES, tid_ >> 6, tid_ & 63); } }
            } else {
                for (int s = bid; s < 128; s += G) wkv_scan_seq3(pt, s, lds);
                for (int c = bid; c < BW; c += G) hyena_unit2(pt, l, c, lds);
                for (int u = bid; u < 512; u += G) gmlp_unit2(pt, l, u, lds);
                if (l + 1 < DEPTH) { __syncthreads(); const int tid_ = opaque_tid(); convert_layer_weights(pt, lds, l + 1, bid * NWAVES + (tid_ >> 6), G * NWAVES, tid_ >> 6, tid_ & 63); }
            }
            } SEAM(p0 + 3);
        }
        if (IN(p0 + 4)) { REP(4) { rwkv_post_phase(pt, l); } SEAM(p0 + 4); }
        if (IN(p0 + 5)) { REP(5) {
            const bf16_t* W = (const bf16_t*)(ws + WS_WBR + l * WBR_L);
#pragma unroll 1
            for (int br = 0; br < 3; ++br) {
                const bf16_t* Y = (const bf16_t*)(ws + (br == 0 ? WS_YA : (br == 1 ? WS_YB : WS_YC)));
                pg8::SegOrder S{Y, W + (size_t)br * D * 1024, M / 256, D / 256, Y, W, 0, 0, G, bid};
                pg8::EpiBf16 E{(bf16_t*)(ws + WS_PBR) + (size_t)br * M * D, D, 0, 8};
                pg8::gemm_phase<pg8::EpiBf16>(lds, 1024, S, E);
            }
            } SEAM(p0 + 5);
        }
        if (IN(p0 + 6)) { REP(6) { merge_phase(pt); } SEAM(p0 + 6); }
        if (IN(p0 + 7)) { REP(7) {
            const bf16_t* Mg = (const bf16_t*)(ws + WS_MERGED); const bf16_t* W = (const bf16_t*)(ws + WS_WOUT + l * WOUT_L);
            pg8::SegOrder S{Mg, W, M / 256, D / 256, Mg, W, 0, 0, G, bid};
            pg8::EpiResidual E{X, D};
            pg8::gemm_phase<pg8::EpiResidual>(lds, D, S, E);
            } SEAM(p0 + 7);
        }
        if (IN(p0 + 8)) { REP(8) { rmsnorm_phase(X, pt.in(I_NORM_FFN_G) + l * D, Hb, nullptr); } SEAM(p0 + 8); }
        if (IN(p0 + 9)) { REP(9) {
            const bf16_t* W = (const bf16_t*)(ws + WS_WGU + l * WGU_L);
            pg8::SegOrder S{Hb, W, M / 256, 2 * DFF / 256, Hb, W, 0, 0, G, bid};
            pg8::EpiSwiGlu E{(bf16_t*)(ws + WS_ACT), DFF};
            pg8::gemm_phase<pg8::EpiSwiGlu>(lds, D, S, E);
            } SEAM(p0 + 9);
        }
        if (IN(p0 + 10)) { REP(10) {
            const bf16_t* Ac = (const bf16_t*)(ws + WS_ACT); const bf16_t* W = (const bf16_t*)(ws + WS_WDN + l * WDN_L);
            pg8::SegOrder S{Ac, W, M / 256, D / 256, Ac, W, 0, 0, G, bid};
            pg8::EpiResidual E{X, D};
            pg8::gemm_phase<pg8::EpiResidual>(lds, DFF, S, E);
            } SEAM(p0 + 10);
        }
    }
    if (IN(PH_FINAL)) rmsnorm_phase((const float*)(pt.ws() + WS_X), pt.in(I_NORM_FINAL_G), nullptr, pt.out());
#undef IN
#undef SEAM
}

extern "C" void kernel_launch(void* const* d_in, const int* in_sizes, int n_in, void* d_out, int out_size, void* d_ws, size_t ws_size, hipStream_t stream) {
    static int grid = 0;
    if (grid == 0) {
        if (n_in != N_INPUTS || out_size != M * D || ws_size < WS_END) { fprintf(stderr, "kernel_launch: unexpected shapes: n_in %d out %d ws %zu (need %zu)\n", n_in, out_size, ws_size, (size_t)WS_END); grid = -1; return; }
        int dev = 0, cus = 0, per_cu = 0;
        if (hipGetDevice(&dev) != hipSuccess || hipDeviceGetAttribute(&cus, hipDeviceAttributeMultiprocessorCount, dev) != hipSuccess) { grid = -1; return; }
        if (hipFuncSetAttribute((const void*)mk_fwd, hipFuncAttributeMaxDynamicSharedMemorySize, LDS_BYTES) != hipSuccess) { fprintf(stderr, "kernel_launch: hipFuncSetAttribute failed\n"); grid = -1; return; }
        if (hipOccupancyMaxActiveBlocksPerMultiprocessor(&per_cu, (const void*)mk_fwd, NTHREADS, LDS_BYTES) != hipSuccess || per_cu < 1) { fprintf(stderr, "kernel_launch: occupancy query says %d\n", per_cu); (void)hipGetLastError(); grid = -1; return; }
        grid = cus;
    }
    if (grid < 0) return;
    (void)hipMemsetAsync((char*)d_ws + WS_CTL, 0, CTL_ZERO_BYTES, stream);
    Args a{};
    for (int i = 0; i < N_INPUTS; ++i) a.in[i] = (const float*)d_in[i];
    a.out = (float*)d_out; a.ws = (unsigned char*)d_ws;
#if MK_LAUNCH_PER_PHASE
    for (int p = 0; p < N_PHASES; ++p) { a.ph_lo = p; a.ph_hi = p + 1; hipLaunchKernelGGL(mk_fwd, dim3(grid), dim3(NTHREADS), LDS_BYTES, stream, a); }
#else
    a.ph_lo = 0; a.ph_hi = N_PHASES;
    hipLaunchKernelGGL(mk_fwd, dim3(grid), dim3(NTHREADS), LDS_BYTES, stream, a);
#endif
}
```
